# Optimizing an MI355X kernel written in HIP

```python
import math
import jax, jax.numpy as jnp
from jax import lax
import numpy as np

D_MODEL = 2048
BATCH = 4
SEQ = 2048
DEPTH = 1
DEC_BATCH = 128
DEC_SEQ = 8
PAST_LEN = 16384
PAGE_SIZE = 128

CHUNK = 128
A_GROUPS = 4
A_GROUP_DIM = 256
A_WIDTH = A_GROUPS * A_GROUP_DIM
R_HEADS = 8
R_QK_DIM = 128
R_V_DIM = 256
R_QK_WIDTH = R_HEADS * R_QK_DIM
R_V_WIDTH = R_HEADS * R_V_DIM
R_CHUNK = 128
N_MEM = 256
M_HEADS = 4
M_HEAD_DIM = 256
M_WIDTH = M_HEADS * M_HEAD_DIM
N_BRANCH = 3
D_FF = -(-8 * D_MODEL // (3 * 256)) * 256
ALPHA = (2.0 * DEPTH) ** 0.25
BETA = (8.0 * DEPTH) ** -0.25
ROPE_BASE = 10000.0
LN_EPS = 1e-5

OFF_AU = N_BRANCH * D_MODEL
OFF_AV = OFF_AU + A_WIDTH
OFF_RQ = OFF_AV + A_WIDTH
OFF_RK = OFF_RQ + R_QK_WIDTH
OFF_RV = OFF_RK + R_QK_WIDTH
OFF_RG = OFF_RV + R_V_WIDTH
OFF_MQ = OFF_RG + R_V_WIDTH
IN_WIDTH = OFF_MQ + M_WIDTH

kernel_name = "gated_hybrid_sgu_retention_memory_step"


def _standardize(x, eps=LN_EPS):
    xf = x.astype(jnp.float32)
    mu = jnp.mean(xf, axis=-1, keepdims=True)
    xc = xf - mu
    var = jnp.mean(xc * xc, axis=-1, keepdims=True)
    return xc * lax.rsqrt(var + eps)


def _rotary(x, pos):
    half = x.shape[-1] // 2
    inv = ROPE_BASE ** (-jnp.arange(half, dtype=jnp.float32) / half)
    ang = pos[:, None] * inv[None, :]
    cos = jnp.cos(ang)[None, :, None, :]
    sin = jnp.sin(ang)[None, :, None, :]
    xf = x.astype(jnp.float32)
    x1, x2 = xf[..., :half], xf[..., half:]
    return jnp.concatenate([x1 * cos - x2 * sin, x1 * sin + x2 * cos], axis=-1)


def _retention(q, k, v, s0):
    B, T, H, dk = q.shape
    dv = v.shape[-1]
    C = min(T, R_CHUNK)
    n = T // C
    log_g = jnp.log1p(-jnp.exp2(-5.0 - jnp.arange(H, dtype=jnp.float32)))
    idx = jnp.arange(C, dtype=jnp.float32)
    diff = idx[:, None] - idx[None, :]
    causal = diff >= 0
    dmask = jnp.where(causal[None], jnp.exp(jnp.where(causal, diff, 0.0)[None] * log_g[:, None, None]), 0.0)
    q_decay = jnp.exp((idx[:, None] + 1.0) * log_g[None, :])
    k_decay = jnp.exp((C - 1.0 - idx)[:, None] * log_g[None, :])
    chunk_decay = jnp.exp(C * log_g)

    def to_chunks(a):
        return a.astype(jnp.float32).reshape(B, n, C, H, a.shape[-1]).transpose(1, 0, 2, 3, 4)

    def step(s, inp):
        qc, kc, vc = inp
        scores = jnp.einsum('bihd,bjhd->bhij', qc, kc) * dmask[None]
        o = (jnp.einsum('bhij,bjhe->bihe', scores, vc)
             + jnp.einsum('bihd,bhde->bihe', qc, s) * q_decay[None, :, :, None])
        s_new = (s * chunk_decay[None, :, None, None]
                 + jnp.einsum('bjhd,bjhe->bhde', kc * k_decay[None, :, :, None], vc))
        return s_new, o

    s_fin, o = lax.scan(step, s0.astype(jnp.float32), (to_chunks(q), to_chunks(k), to_chunks(v)))
    o = o.transpose(1, 0, 2, 3, 4).reshape(B, T, H, dv)
    return o, s_fin


def _spatial_gate(u, v, w_s, b_s):
    B, T, G, dg = v.shape
    C = min(T, CHUNK)
    n = T // C
    w = jnp.tril(w_s[:, :C, :C])
    vc = v.reshape(B, n, C, G, dg)
    z = jnp.einsum('gij,bnjgd->bnigd', w, vc) + b_s[:, :C].T[None, None, :, :, None]
    return u * z.reshape(B, T, G, dg)


def _mem_attend(q, mk, mv):
    s = jnp.einsum('bthd,bmhd->bhtm', q.astype(jnp.float32), mk.astype(jnp.float32)) * (M_HEAD_DIM ** -0.5)
    p = jax.nn.softmax(s, axis=-1)
    return jnp.einsum('bhtm,bmhe->bthe', p, mv.astype(jnp.float32))


def _layer(x, pos_start, ret_s0, mem_k, mem_v, p):
    B, T, _ = x.shape
    pos = pos_start + jnp.arange(T, dtype=jnp.float32)
    h = x @ p['w_in']
    gates = jax.nn.sigmoid(h[..., :OFF_AU].astype(jnp.float32)).reshape(B, T, N_BRANCH, D_MODEL)
    u = jax.nn.gelu(h[..., OFF_AU:OFF_AV]).reshape(B, T, A_GROUPS, A_GROUP_DIM)
    va = jax.nn.gelu(h[..., OFF_AV:OFF_RQ]).reshape(B, T, A_GROUPS, A_GROUP_DIM)
    va = _standardize(va) * p['sgu_ln_g'] + p['sgu_ln_b']
    ya = _spatial_gate(u, va, p['sgu_w'], p['sgu_b']).reshape(B, T, A_WIDTH) @ p['w_proj_a']
    q = _rotary(h[..., OFF_RQ:OFF_RK].reshape(B, T, R_HEADS, R_QK_DIM), pos)
    k = _rotary(h[..., OFF_RK:OFF_RV].reshape(B, T, R_HEADS, R_QK_DIM), pos) * (R_QK_DIM ** -0.5)
    vr = h[..., OFF_RV:OFF_RG].reshape(B, T, R_HEADS, R_V_DIM)
    o, s_fin = _retention(q, k, vr, ret_s0)
    o = (_standardize(o) * p['ret_gn_g'].reshape(R_HEADS, R_V_DIM)).reshape(B, T, R_V_WIDTH)
    yb = (jax.nn.silu(h[..., OFF_RG:OFF_MQ].astype(jnp.float32)) * o) @ p['w_proj_b']
    qm = h[..., OFF_MQ:].reshape(B, T, M_HEADS, M_HEAD_DIM)
    yc = _mem_attend(qm, mem_k, mem_v).reshape(B, T, M_WIDTH) @ p['w_proj_c']
    merged = gates[:, :, 0] * ya + gates[:, :, 1] * yb + gates[:, :, 2] * yc
    x1 = _standardize(ALPHA * x + merged @ p['w_out']) * p['ln1_g'] + p['ln1_b']
    f = (jax.nn.silu(x1 @ p['w_ffn_gate']) * (x1 @ p['w_ffn_up'])) @ p['w_ffn_down']
    y = _standardize(ALPHA * x1 + f) * p['ln2_g'] + p['ln2_b']
    return y, s_fin, va


def setup_inputs(seed: int = 0) -> dict:
    key = jax.random.key(seed)
    ks = jax.random.split(key, 32)
    f32 = jnp.float32

    def nrm(k, shape, scale):
        return jax.random.normal(k, shape, f32) * scale

    L = DEPTH
    return {
        'x_prompt': nrm(ks[0], (BATCH, SEQ, D_MODEL), 1.0),
        'x_sample': nrm(ks[1], (DEC_BATCH, DEC_SEQ, D_MODEL), 1.0),
        'mem_prompt': nrm(ks[2], (BATCH, N_MEM, D_MODEL), 1.0),
        'state_ret': nrm(ks[3], (L, DEC_BATCH, R_HEADS, R_QK_DIM, R_V_DIM), 0.1),
        'cache_mem_k': nrm(ks[4], (L, DEC_BATCH, N_MEM, M_HEADS, M_HEAD_DIM), 1.0),
        'cache_mem_v': nrm(ks[5], (L, DEC_BATCH, N_MEM, M_HEADS, M_HEAD_DIM), 1.0),
        'w_in': nrm(ks[6], (L, D_MODEL, IN_WIDTH), D_MODEL ** -0.5),
        'sgu_ln_g': 1.0 + nrm(ks[7], (L, A_GROUPS, A_GROUP_DIM), 0.02),
        'sgu_ln_b': nrm(ks[8], (L, A_GROUPS, A_GROUP_DIM), 0.02),
        'sgu_w': nrm(ks[9], (L, A_GROUPS, CHUNK, CHUNK), CHUNK ** -0.5),
        'sgu_b': 1.0 + nrm(ks[10], (L, A_GROUPS, CHUNK), 0.02),
        'w_proj_a': nrm(ks[11], (L, A_WIDTH, D_MODEL), BETA * A_WIDTH ** -0.5),
        'ret_gn_g': 1.0 + nrm(ks[12], (L, R_V_WIDTH), 0.02),
        'w_proj_b': nrm(ks[13], (L, R_V_WIDTH, D_MODEL), BETA * R_V_WIDTH ** -0.5),
        'w_mem_k': nrm(ks[14], (L, D_MODEL, M_WIDTH), D_MODEL ** -0.5),
        'w_mem_v': nrm(ks[15], (L, D_MODEL, M_WIDTH), D_MODEL ** -0.5),
        'w_proj_c': nrm(ks[16], (L, M_WIDTH, D_MODEL), BETA * M_WIDTH ** -0.5),
        'w_out': nrm(ks[17], (L, D_MODEL, D_MODEL), BETA * D_MODEL ** -0.5),
        'ln1_g': 1.0 + nrm(ks[18], (L, D_MODEL), 0.02),
        'ln1_b': nrm(ks[19], (L, D_MODEL), 0.02),
        'w_ffn_gate': nrm(ks[20], (L, D_MODEL, D_FF), D_MODEL ** -0.5),
        'w_ffn_up': nrm(ks[21], (L, D_MODEL, D_FF), D_MODEL ** -0.5),
        'w_ffn_down': nrm(ks[22], (L, D_FF, D_MODEL), BETA * D_FF ** -0.5),
        'ln2_g': 1.0 + nrm(ks[23], (L, D_MODEL), 0.02),
        'ln2_b': nrm(ks[24], (L, D_MODEL), 0.02),
    }


def reference(x_prompt, x_sample, mem_prompt, state_ret, cache_mem_k, cache_mem_v,
              w_in, sgu_ln_g, sgu_ln_b, sgu_w, sgu_b, w_proj_a, ret_gn_g, w_proj_b,
              w_mem_k, w_mem_v, w_proj_c, w_out, ln1_g, ln1_b,
              w_ffn_gate, w_ffn_up, w_ffn_down, ln2_g, ln2_b):
    bp = x_prompt.shape[0]
    h_p, h_s = x_prompt, x_sample
    ret_p, mk_p_all, mv_p_all, ret_s, cv_s = [], [], [], [], []
    for l in range(DEPTH):
        p = {
            'w_in': w_in[l], 'sgu_ln_g': sgu_ln_g[l], 'sgu_ln_b': sgu_ln_b[l],
            'sgu_w': sgu_w[l], 'sgu_b': sgu_b[l], 'w_proj_a': w_proj_a[l],
            'ret_gn_g': ret_gn_g[l], 'w_proj_b': w_proj_b[l], 'w_proj_c': w_proj_c[l],
            'w_out': w_out[l], 'ln1_g': ln1_g[l], 'ln1_b': ln1_b[l],
            'w_ffn_gate': w_ffn_gate[l], 'w_ffn_up': w_ffn_up[l], 'w_ffn_down': w_ffn_down[l],
            'ln2_g': ln2_g[l], 'ln2_b': ln2_b[l],
        }
        mk_p = (mem_prompt @ w_mem_k[l]).reshape(bp, N_MEM, M_HEADS, M_HEAD_DIM)
        mv_p = (mem_prompt @ w_mem_v[l]).reshape(bp, N_MEM, M_HEADS, M_HEAD_DIM)
        s0 = jnp.zeros((bp, R_HEADS, R_QK_DIM, R_V_DIM), jnp.float32)
        h_p, s_p, _ = _layer(h_p, 0.0, s0, mk_p, mv_p, p)
        h_s, s_s, v_s = _layer(h_s, float(PAST_LEN), state_ret[l], cache_mem_k[l], cache_mem_v[l], p)
        ret_p.append(s_p)
        mk_p_all.append(mk_p)
        mv_p_all.append(mv_p)
        ret_s.append(s_s)
        cv_s.append(v_s)
    return (h_p, h_s, jnp.stack(ret_p), jnp.stack(mk_p_all), jnp.stack(mv_p_all), jnp.stack(ret_s), jnp.stack(cv_s))
```

```cpp
#include <hip/hip_runtime.h>
#include <hip/hip_cooperative_groups.h>
#include <cstdio>
namespace cg = cooperative_groups;

#define LAS __attribute__((address_space(3)))
typedef unsigned short bf16_t;
typedef short bf16x8 __attribute__((ext_vector_type(8)));
typedef short s16x4 __attribute__((ext_vector_type(4)));
typedef float f32x4 __attribute__((ext_vector_type(4)));
typedef unsigned u32x2 __attribute__((ext_vector_type(2)));
typedef unsigned u32x4 __attribute__((ext_vector_type(4)));

constexpr int DM = 2048, NTOK = 9216, TOKP = 8192, INW = 15360, DFF = 5632;
constexpr int OFF_AU = 6144, OFF_AV = 7168, OFF_RQ = 8192, OFF_RK = 9216, OFF_RV = 10240, OFF_RG = 12288, OFF_MQ = 14336;
constexpr float ALPHA = 1.189207115002721f;
constexpr float LN_EPS = 1e-5f;

constexpr size_t al256(size_t x) { return (x + 255) & ~(size_t)255; }
constexpr size_t WS_CTL = 0;
constexpr size_t WS_BAR = 4096;
constexpr size_t WS_CTL_BYTES = 32768;
constexpr size_t WS_ROPE = 32768;
constexpr size_t WS_XB = al256(WS_ROPE + 2056ull * 64 * 2 * 4);
constexpr size_t WS_WIN = WS_XB + (size_t)NTOK * DM * 2;
constexpr size_t WS_WCAT = WS_WIN + (size_t)INW * DM * 2;
constexpr size_t WS_WOUT = WS_WCAT + 2048ull * 4096 * 2;
constexpr size_t WS_WGU = WS_WOUT + 2048ull * 2048 * 2;
constexpr size_t WS_WDN = WS_WGU + 11264ull * 2048 * 2;
constexpr size_t WS_WMKV = WS_WDN + 2048ull * 5632 * 2;
constexpr size_t WS_MEMB = WS_WMKV + 2048ull * 2048 * 2;
constexpr size_t WS_GATES = WS_MEMB + 1024ull * 2048 * 2;
constexpr size_t WS_U = WS_GATES + (size_t)NTOK * 6144 * 2;
constexpr size_t WS_VA = WS_U + (size_t)NTOK * 1024 * 2;
constexpr size_t WS_RQ = WS_VA + (size_t)NTOK * 1024 * 2;
constexpr size_t WS_RK = WS_RQ + (size_t)NTOK * 1024 * 2;
constexpr size_t WS_RV = WS_RK + (size_t)NTOK * 1024 * 2;
constexpr size_t WS_RG = WS_RV + (size_t)NTOK * 2048 * 2;
constexpr size_t WS_MQ = WS_RG + (size_t)NTOK * 2048 * 2;
constexpr size_t WS_MKB = WS_MQ + (size_t)NTOK * 1024 * 2;
constexpr size_t WS_MVB = WS_MKB + 1024ull * 1024 * 2;
constexpr size_t WS_RO = WS_MVB + 1024ull * 1024 * 2;
constexpr size_t WS_PART = WS_RO + 8192ull * 2048 * 2;
constexpr size_t WS_END = WS_PART + 256ull * 65536 * 4;
constexpr size_t WS_ACAT = WS_XB;
constexpr size_t WS_MERGED = WS_U;
constexpr size_t WS_MERGEDB = WS_RV;
constexpr size_t WS_X1 = WS_ACAT;
constexpr size_t WS_X1B = WS_RG;
constexpr size_t WS_ACT = WS_GATES;
constexpr size_t WS_YPRE = WS_MERGED;

constexpr size_t O_Y = 0, O_SRP = 18874368, O_MK = 19922944, O_MV = 20971520, O_SRS = 22020096, O_CV = 55574528;

constexpr int LDS_BYTES = 155648;
constexpr int LDS_CTL = 155632;

struct Params {
  const float* in[25];
  float* out;
  unsigned char* ws;
  int ph_lo, ph_hi;
};

typedef float f32x2 __attribute__((ext_vector_type(2)));
typedef __bf16 bf16x2_t __attribute__((ext_vector_type(2)));
__device__ __forceinline__ unsigned cvt_pk(float lo, float hi) { const f32x2 v = {lo, hi}; const bf16x2_t b = __builtin_convertvector(v, bf16x2_t); return __builtin_bit_cast(unsigned, b); }
__device__ __forceinline__ float bflo(unsigned u) { return __uint_as_float(u << 16); }
__device__ __forceinline__ float bfhi(unsigned u) { return __uint_as_float(u & 0xffff0000u); }
__device__ __forceinline__ u32x2 pack4(f32x4 v) { u32x2 r; r[0] = cvt_pk(v[0], v[1]); r[1] = cvt_pk(v[2], v[3]); return r; }
__device__ __forceinline__ f32x4 unpack4(u32x2 u) { f32x4 r; r[0] = bflo(u[0]); r[1] = bfhi(u[0]); r[2] = bflo(u[1]); r[3] = bfhi(u[1]); return r; }
__device__ __forceinline__ float sigmoidf_(float x) { return __builtin_amdgcn_rcpf(1.0f + __expf(-x)); }
__device__ __forceinline__ float gelu_tanh(float x) { const float z = 1.5957691216057308f * (x + 0.044715f * x * x * x); return x * sigmoidf_(z); }
__device__ __forceinline__ float siluf_(float x) { return x * sigmoidf_(x); }
__device__ __forceinline__ float wave_sum(float v) {
#pragma unroll
  for (int o = 32; o >= 1; o >>= 1) v += __shfl_xor(v, o);
  return v;
}
__device__ __forceinline__ float wave_max(float v) {
#pragma unroll
  for (int o = 32; o >= 1; o >>= 1) v = fmaxf(v, __shfl_xor(v, o));
  return v;
}
typedef short v4i16_t __attribute__((ext_vector_type(4)));
__device__ __forceinline__ s16x4 vtr(const LAS unsigned char* p) { return __builtin_bit_cast(s16x4, __builtin_amdgcn_ds_read_tr16_b64_v4i16((LAS v4i16_t*)p)); }
__device__ __forceinline__ bf16x8 ldfrag(const LAS unsigned char* img, int row, int k, int strideB) { return *(const LAS bf16x8*)(img + row * strideB + k * 2); }
__device__ __forceinline__ bf16x8 ldfrag_tr(const LAS unsigned char* img, int kr0, int kr1, int n0, int strideB, int lane) {
  const int i = lane & 15;
  const LAS unsigned char* a0 = img + (kr0 + (i >> 2)) * strideB + (n0 + 4 * (i & 3)) * 2;
  const LAS unsigned char* a1 = img + (kr1 + (i >> 2)) * strideB + (n0 + 4 * (i & 3)) * 2;
  const s16x4 lo = vtr(a0), hi = vtr(a1);
  return (bf16x8){lo[0], lo[1], lo[2], lo[3], hi[0], hi[1], hi[2], hi[3]};
}
#define MFMA16(a, b, c) __builtin_amdgcn_mfma_f32_16x16x32_bf16((a), (b), (c), 0, 0, 0)

constexpr int BM = 256, BK = 64, HALF = 128, HTB = HALF * BK * 2;
__device__ __forceinline__ int lds_byte(int r, int c) { const int st = (r >> 4) * 2 + (c >> 5), rr = r & 15, cc = c & 31, ob = rr * 64 + cc * 2; return st * 1024 + (ob ^ (((ob >> 9) & 1) << 5)); }
__device__ __forceinline__ void stage_rc(int b, int& R, int& C) { const int st = b / 1024, sb = b % 1024, swz = sb ^ (((sb >> 9) & 1) << 5); R = (st >> 1) * 16 + swz / 64; C = (st & 1) * 32 + (swz % 64) / 2; }

struct Unit { const char* A; const char* B; int nt, pm, pn, kind; };

__device__ __forceinline__ void static_tile(int nM, int nN, int L, int& pm, int& pn) {
  const int nwg = nM * nN; int wgid = L;
  { const int q = nwg / 8, r = nwg % 8, xcd = wgid % 8, off = wgid / 8; wgid = (xcd < r ? xcd * (q + 1) : r * (q + 1) + (xcd - r) * q) + off; }
  const int nig = 8 * nN, gid = wgid / nig, fm = gid * 8, gsz = (nM - fm) < 8 ? (nM - fm) : 8;
  pm = fm + ((wgid % nig) % gsz); pn = (wgid % nig) / gsz;
}

__device__ __forceinline__ bool next_unit(const Params& p, int gph, int i, Unit& u) {
  const int G = gridDim.x, c = blockIdx.x;
  const char* ws = (const char*)p.ws;
  if (gph == 0) {
    const int L = i * G + c;
    if (L < 2160) {
      static_tile(36, 60, L, u.pm, u.pn);
      u.A = ws + WS_XB + (size_t)u.pm * 256 * 2048 * 2; u.B = ws + WS_WIN + (size_t)u.pn * 256 * 2048 * 2; u.nt = 32;
      const int pn = u.pn;
      u.kind = pn < 24 ? 0 : pn < 28 ? 1 : pn < 32 ? 2 : pn < 36 ? 3 : pn < 40 ? 4 : pn < 48 ? 5 : pn < 56 ? 6 : 7;
      return true;
    }
    if (L < 2192) {
      const int mk = L - 2160; u.pm = mk >> 3; u.pn = mk & 7;
      u.A = ws + WS_MEMB + (size_t)u.pm * 256 * 2048 * 2; u.B = ws + WS_WMKV + (size_t)u.pn * 256 * 2048 * 2; u.nt = 32; u.kind = 8;
      return true;
    }
    return false;
  } else if (gph == 1) {
    if (G == 256 && i >= 3) {
      if (i > 3) return false;
      const int su = c, part = su & 7; int pm, pn;
      static_tile(36, 8, 256 + (su >> 3), pm, pn);
      const int seg = part < 2 ? 0 : part < 6 ? 1 : 2;
      const size_t ko = part * 512;
      u.A = ws + WS_ACAT + ((size_t)pm * 256 * 4096 + ko) * 2; u.B = ws + WS_WCAT + ((size_t)pn * 256 * 4096 + ko) * 2;
      u.nt = 8; u.kind = 17 + seg; u.pm = su; u.pn = pm * 8 + pn;
      return true;
    }
    const int L = (i / 3) * G + c, seg = i % 3;
    if (L >= (G == 256 ? 256 : 288)) return false;
    static_tile(36, 8, L, u.pm, u.pn);
    const size_t so = seg == 0 ? 0 : seg == 1 ? 1024 : 3072;
    u.A = ws + WS_ACAT + ((size_t)u.pm * 256 * 4096 + so) * 2; u.B = ws + WS_WCAT + ((size_t)u.pn * 256 * 4096 + so) * 2;
    u.nt = seg == 1 ? 32 : 16; u.kind = 9 + seg;
    return true;
  } else if (gph == 2) {
    const int v = i * G + c; if (v >= 512) return false;
    if (v < 256) {
      static_tile(36, 8, v, u.pm, u.pn);
      u.A = ws + WS_MERGEDB + (size_t)u.pm * 256 * 2048 * 2; u.B = ws + WS_WOUT + (size_t)u.pn * 256 * 2048 * 2; u.nt = 32; u.kind = 12;
    } else {
      const int su = v - 256, s = su & 7; int pm, pn;
      static_tile(36, 8, 256 + (su >> 3), pm, pn);
      u.A = ws + WS_MERGEDB + ((size_t)pm * 256 * 2048 + s * 256) * 2; u.B = ws + WS_WOUT + ((size_t)pn * 256 * 2048 + s * 256) * 2; u.nt = 4; u.kind = 16;
      u.pm = su; u.pn = 0;
    }
    return true;
  } else if (gph == 3) {
    const int L = i * G + c;
    if (G == 256 && L >= 1536) {
      const int su = L - 1536; if (su >= 192) return false;
      int pm, pn; static_tile(36, 44, 1536 + (su >> 2), pm, pn);
      const size_t ko = (size_t)(su & 3) * 512;
      u.A = ws + WS_X1B + ((size_t)pm * 256 * 2048 + ko) * 2; u.B = ws + WS_WGU + ((size_t)pn * 256 * 2048 + ko) * 2; u.nt = 8; u.kind = 16;
      u.pm = su; u.pn = 0;
      return true;
    }
    if (L >= 1584) return false;
    static_tile(36, 44, L, u.pm, u.pn);
    u.A = ws + WS_X1B + (size_t)u.pm * 256 * 2048 * 2; u.B = ws + WS_WGU + (size_t)u.pn * 256 * 2048 * 2; u.nt = 32; u.kind = 13;
    return true;
  } else {
    const int v = i * G + c; if (v >= 512) return false;
    if (v < 256) {
      static_tile(36, 8, v, u.pm, u.pn);
      u.A = ws + WS_ACT + (size_t)u.pm * 256 * 5632 * 2; u.B = ws + WS_WDN + (size_t)u.pn * 256 * 5632 * 2; u.nt = 88; u.kind = 14;
    } else {
      const int su = v - 256, s = su & 7; int pm, pn;
      static_tile(36, 8, 256 + (su >> 3), pm, pn);
      const int kt0 = s < 4 ? 12 * s : 48 + 10 * (s - 4);
      u.A = ws + WS_ACT + ((size_t)pm * 256 * 5632 + kt0 * 64) * 2; u.B = ws + WS_WDN + ((size_t)pn * 256 * 5632 + kt0 * 64) * 2; u.nt = s < 4 ? 12 : 10; u.kind = 16;
      u.pm = su; u.pn = 0;
    }
    return true;
  }
}

__device__ __forceinline__ void epilogue(const Params& p, const Unit& u, const f32x4 (&acc)[2][2][4][2], int wr, int wc, int fr, int fq) {
  unsigned char* ws = p.ws;
  const int row0 = u.pm * 256 + wr * 64 + fr;
  const int ct0 = wc * 32 + 4 * fq;
  const int kind = u.kind;
  if (kind <= 2 || (kind >= 5 && kind <= 7)) {
    bf16_t* dst; int ld, cb, act; float scale = 1.0f;
    if (kind == 0) { dst = (bf16_t*)(ws + WS_GATES); ld = 6144; cb = u.pn * 256; act = 1; }
    else if (kind == 1) { dst = (bf16_t*)(ws + WS_U); ld = 1024; cb = u.pn * 256 - OFF_AU; act = 2; }
    else if (kind == 2) { dst = (bf16_t*)(ws + WS_VA); ld = 1024; cb = u.pn * 256 - OFF_AV; act = 2; }
    else if (kind == 5) { dst = (bf16_t*)(ws + WS_RV); ld = 2048; cb = u.pn * 256 - OFF_RV; act = 0; }
    else if (kind == 6) { dst = (bf16_t*)(ws + WS_RG); ld = 2048; cb = u.pn * 256 - OFF_RG; act = 3; }
    else { dst = (bf16_t*)(ws + WS_MQ); ld = 1024; cb = u.pn * 256 - OFF_MQ; act = 0; scale = 0.0625f; }
#pragma unroll
    for (int ai = 0; ai < 2; ++ai)
#pragma unroll
      for (int m = 0; m < 4; ++m) {
        bf16_t* rp = dst + (size_t)(row0 + ai * 128 + m * 16) * ld + cb + ct0;
#pragma unroll
        for (int bj = 0; bj < 2; ++bj)
#pragma unroll
          for (int n = 0; n < 2; ++n) {
            f32x4 v = acc[ai][bj][m][n];
            if (act == 1) { v[0] = sigmoidf_(v[0]); v[1] = sigmoidf_(v[1]); v[2] = sigmoidf_(v[2]); v[3] = sigmoidf_(v[3]); }
            else if (act == 2) { v[0] = gelu_tanh(v[0]); v[1] = gelu_tanh(v[1]); v[2] = gelu_tanh(v[2]); v[3] = gelu_tanh(v[3]); }
            else if (act == 3) { v[0] = siluf_(v[0]); v[1] = siluf_(v[1]); v[2] = siluf_(v[2]); v[3] = siluf_(v[3]); }
            else { v = v * scale; }
            *(u32x2*)(rp + bj * 128 + n * 16) = pack4(v);
          }
      }
  } else if (kind == 3 || kind == 4) {
    bf16_t* dst = (bf16_t*)(ws + (kind == 3 ? WS_RQ : WS_RK));
    const float scale = kind == 3 ? 1.0f : 0.08838834764831845f;
    const int hb = (u.pn - (kind == 3 ? 32 : 36)) * 2;
    const float* rope = (const float*)(ws + WS_ROPE);
    const int ii = 16 * wc + 4 * fq;
#pragma unroll
    for (int ai = 0; ai < 2; ++ai) {
      f32x4 cs[4][2];
#pragma unroll
      for (int m = 0; m < 4; ++m) {
        const int row = row0 + ai * 128 + m * 16;
        const int pidx = row < TOKP ? (row & 2047) : 2048 + ((row - TOKP) & 7);
        cs[m][0] = *(const f32x4*)(rope + ((size_t)pidx * 64 + ii) * 2);
        cs[m][1] = *(const f32x4*)(rope + ((size_t)pidx * 64 + ii) * 2 + 4);
      }
#pragma unroll
      for (int m = 0; m < 4; ++m) {
        const int row = row0 + ai * 128 + m * 16;
        const f32x4 cs0 = cs[m][0], cs1 = cs[m][1];
#pragma unroll
        for (int bj = 0; bj < 2; ++bj) {
          const f32x4 x1 = acc[ai][bj][m][0] * scale, x2 = acc[ai][bj][m][1] * scale;
          f32x4 o1, o2;
          o1[0] = x1[0] * cs0[0] - x2[0] * cs0[1]; o2[0] = x1[0] * cs0[1] + x2[0] * cs0[0];
          o1[1] = x1[1] * cs0[2] - x2[1] * cs0[3]; o2[1] = x1[1] * cs0[3] + x2[1] * cs0[2];
          o1[2] = x1[2] * cs1[0] - x2[2] * cs1[1]; o2[2] = x1[2] * cs1[1] + x2[2] * cs1[0];
          o1[3] = x1[3] * cs1[2] - x2[3] * cs1[3]; o2[3] = x1[3] * cs1[3] + x2[3] * cs1[2];
          bf16_t* rp = dst + (size_t)row * 1024 + (hb + bj) * 128 + ii;
          *(u32x2*)(rp) = pack4(o1);
          *(u32x2*)(rp + 64) = pack4(o2);
        }
      }
    }
  } else if (kind == 8) {
    const bool isv = u.pn >= 4;
    float* of = p.out + (isv ? O_MV : O_MK);
    bf16_t* ob = (bf16_t*)(ws + (isv ? WS_MVB : WS_MKB));
    const int cb = (u.pn & 3) * 256;
#pragma unroll
    for (int ai = 0; ai < 2; ++ai)
#pragma unroll
      for (int m = 0; m < 4; ++m) {
        const size_t ro = (size_t)(row0 + ai * 128 + m * 16) * 1024 + cb + ct0;
#pragma unroll
        for (int bj = 0; bj < 2; ++bj)
#pragma unroll
          for (int n = 0; n < 2; ++n) {
            const f32x4 v = acc[ai][bj][m][n];
            *(f32x4*)(of + ro + bj * 128 + n * 16) = v;
            *(u32x2*)(ob + ro + bj * 128 + n * 16) = pack4(v);
          }
      }
  } else if (kind >= 9 && kind <= 11) {
    const int seg = kind - 9;
    const bf16_t* gates = (const bf16_t*)(ws + WS_GATES);
    float* mf = (float*)(ws + WS_MERGED);
    bf16_t* mb = (bf16_t*)(ws + WS_MERGEDB);
    const int cb = u.pn * 256 + ct0;
#pragma unroll
    for (int ai = 0; ai < 2; ++ai)
#pragma unroll
      for (int mp = 0; mp < 2; ++mp) {
        u32x2 gr[2][2][2]; f32x4 mv[2][2][2];
#pragma unroll
        for (int mm = 0; mm < 2; ++mm)
#pragma unroll
          for (int bj = 0; bj < 2; ++bj)
#pragma unroll
            for (int n = 0; n < 2; ++n) {
              const size_t row = (size_t)(row0 + ai * 128 + (mp * 2 + mm) * 16);
              const int col = cb + bj * 128 + n * 16;
              gr[mm][bj][n] = __builtin_nontemporal_load((const u32x2*)(gates + row * 6144 + seg * 2048 + col));
              if (seg > 0) mv[mm][bj][n] = *(const f32x4*)(mf + row * 2048 + col);
            }
#pragma unroll
        for (int mm = 0; mm < 2; ++mm)
#pragma unroll
          for (int bj = 0; bj < 2; ++bj)
#pragma unroll
            for (int n = 0; n < 2; ++n) {
              const size_t row = (size_t)(row0 + ai * 128 + (mp * 2 + mm) * 16);
              const int col = cb + bj * 128 + n * 16;
              f32x4 v = acc[ai][bj][mp * 2 + mm][n] * unpack4(gr[mm][bj][n]);
              if (seg > 0) v += mv[mm][bj][n];
              if (seg < 2) *(f32x4*)(mf + row * 2048 + col) = v;
              else *(u32x2*)(mb + row * 2048 + col) = pack4(v);
            }
      }
  } else if (kind == 12) {
    float* xo = (float*)(ws + WS_X1);
    const int cb = u.pn * 256 + ct0;
#pragma unroll
    for (int ai = 0; ai < 2; ++ai)
#pragma unroll
      for (int mp = 0; mp < 2; ++mp) {
        f32x4 xv[2][2][2];
#pragma unroll
        for (int mm = 0; mm < 2; ++mm) {
          const int row = row0 + ai * 128 + (mp * 2 + mm) * 16;
          const float* xr = row < TOKP ? p.in[0] + (size_t)row * 2048 : p.in[1] + (size_t)(row - TOKP) * 2048;
#pragma unroll
          for (int bj = 0; bj < 2; ++bj)
#pragma unroll
            for (int n = 0; n < 2; ++n) xv[mm][bj][n] = __builtin_nontemporal_load((const f32x4*)(xr + cb + bj * 128 + n * 16));
        }
#pragma unroll
        for (int mm = 0; mm < 2; ++mm) {
          const int row = row0 + ai * 128 + (mp * 2 + mm) * 16;
#pragma unroll
          for (int bj = 0; bj < 2; ++bj)
#pragma unroll
            for (int n = 0; n < 2; ++n) *(f32x4*)(xo + (size_t)row * 2048 + cb + bj * 128 + n * 16) = xv[mm][bj][n] * ALPHA + acc[ai][bj][mp * 2 + mm][n];
        }
      }
  } else if (kind == 13) {
    bf16_t* act = (bf16_t*)(ws + WS_ACT);
    const int fb = u.pn * 128 + 16 * wc + 4 * fq;
#pragma unroll
    for (int ai = 0; ai < 2; ++ai)
#pragma unroll
      for (int m = 0; m < 4; ++m) {
        const size_t row = (size_t)(row0 + ai * 128 + m * 16);
#pragma unroll
        for (int bj = 0; bj < 2; ++bj) {
          const f32x4 g = acc[ai][bj][m][0], uu = acc[ai][bj][m][1];
          f32x4 v; v[0] = siluf_(g[0]) * uu[0]; v[1] = siluf_(g[1]) * uu[1]; v[2] = siluf_(g[2]) * uu[2]; v[3] = siluf_(g[3]) * uu[3];
          *(u32x2*)(act + row * DFF + fb + bj * 64) = pack4(v);
        }
      }
  } else if (kind >= 17) {
    const int seg = kind - 17;
    const bf16_t* gates = (const bf16_t*)(ws + WS_GATES);
    float* pt = (float*)(ws + WS_PART) + (size_t)u.pm * 65536;
    const int trow = (u.pn >> 3) * 256, tcol = (u.pn & 7) * 256;
#pragma unroll
    for (int ai = 0; ai < 2; ++ai)
#pragma unroll
      for (int mp = 0; mp < 2; ++mp) {
        u32x2 gr[2][2][2];
#pragma unroll
        for (int mm = 0; mm < 2; ++mm)
#pragma unroll
          for (int bj = 0; bj < 2; ++bj)
#pragma unroll
            for (int n = 0; n < 2; ++n) {
              const size_t row = (size_t)(trow + wr * 64 + fr + ai * 128 + (mp * 2 + mm) * 16);
              gr[mm][bj][n] = __builtin_nontemporal_load((const u32x2*)(gates + row * 6144 + seg * 2048 + tcol + ct0 + bj * 128 + n * 16));
            }
#pragma unroll
        for (int mm = 0; mm < 2; ++mm)
#pragma unroll
          for (int bj = 0; bj < 2; ++bj)
#pragma unroll
            for (int n = 0; n < 2; ++n) {
              const int rl = wr * 64 + fr + ai * 128 + (mp * 2 + mm) * 16;
              *(f32x4*)(pt + rl * 256 + ct0 + bj * 128 + n * 16) = acc[ai][bj][mp * 2 + mm][n] * unpack4(gr[mm][bj][n]);
            }
      }
  } else if (kind == 16) {
    float* pt = (float*)(ws + WS_PART) + (size_t)u.pm * 65536;
#pragma unroll
    for (int ai = 0; ai < 2; ++ai)
#pragma unroll
      for (int m = 0; m < 4; ++m) {
        float* rp = pt + (wr * 64 + fr + ai * 128 + m * 16) * 256 + ct0;
#pragma unroll
        for (int bj = 0; bj < 2; ++bj)
#pragma unroll
          for (int n = 0; n < 2; ++n) *(f32x4*)(rp + bj * 128 + n * 16) = acc[ai][bj][m][n];
      }
  } else {
    const float* x1 = (const float*)(ws + WS_X1);
    float* yo = (float*)(ws + WS_YPRE);
    const int cb = u.pn * 256 + ct0;
#pragma unroll
    for (int ai = 0; ai < 2; ++ai)
#pragma unroll
      for (int mp = 0; mp < 2; ++mp) {
        f32x4 xv[2][2][2];
#pragma unroll
        for (int mm = 0; mm < 2; ++mm) {
          const size_t row = (size_t)(row0 + ai * 128 + (mp * 2 + mm) * 16);
#pragma unroll
          for (int bj = 0; bj < 2; ++bj)
#pragma unroll
            for (int n = 0; n < 2; ++n) xv[mm][bj][n] = __builtin_nontemporal_load((const f32x4*)(x1 + row * 2048 + cb + bj * 128 + n * 16));
        }
#pragma unroll
        for (int mm = 0; mm < 2; ++mm) {
          const size_t row = (size_t)(row0 + ai * 128 + (mp * 2 + mm) * 16);
#pragma unroll
          for (int bj = 0; bj < 2; ++bj)
#pragma unroll
            for (int n = 0; n < 2; ++n) *(f32x4*)(yo + row * 2048 + cb + bj * 128 + n * 16) = xv[mm][bj][n] * ALPHA + acc[ai][bj][mp * 2 + mm][n];
        }
      }
  }
}

__device__ __forceinline__ void gemm_phase(const Params& p, LAS unsigned char* lds, int gph, unsigned ldB  ) {
  int tid = threadIdx.x; asm volatile("" : "+v"(tid));
  const int wid = __builtin_amdgcn_readfirstlane(tid >> 6), lane = tid & 63, wr = wid >> 2, wc = wid & 3, fr = lane & 15, fq = lane >> 4;
  unsigned voff[2];
#pragma unroll
  for (int i = 0; i < 2; ++i) { int R, C; stage_rc(tid * 16 + i * 8192, R, C); voff[i] = (unsigned)R * ldB + (unsigned)C * 2u; }
  const size_t kstep = (size_t)(BK * 2);
  const size_t hstep = (size_t)HALF * ldB;
  const unsigned ldsw = (unsigned)wid * 1024u;
  const int aoff = lds_byte(wr * 64 + fr, fq * 8), boff = lds_byte(wc * 32 + fr, fq * 8);
#define PG8_SA(b, h) (((b) * 2 + (h)) * HTB)
#define PG8_SB(b, h) ((4 + (b) * 2 + (h)) * HTB)
#define PG8_STAGE(bufoff, gbase) do { _Pragma("unroll") for (int _i = 0; _i < 2; ++_i) \
        __builtin_amdgcn_global_load_lds((const unsigned*)((const char*)(gbase) + voff[_i]), (LAS unsigned*)(lds + (bufoff) + ldsw + _i * 8192), 16, 0, 0); } while (0)
#define PG8_LDA(dst, b, h) do { _Pragma("unroll") for (int m = 0; m < 4; ++m) _Pragma("unroll") for (int k = 0; k < 2; ++k) dst[m][k] = *(const LAS bf16x8*)(lds + PG8_SA(b, h) + aoff + m * 2048 + k * 1024); } while (0)
#define PG8_LDB(dst, b, h) do { _Pragma("unroll") for (int n = 0; n < 2; ++n) _Pragma("unroll") for (int k = 0; k < 2; ++k) dst[n][k] = *(const LAS bf16x8*)(lds + PG8_SB(b, h) + boff + n * 2048 + k * 1024); } while (0)
#define PG8_MMA(ai, bj, At, Bt) do { __builtin_amdgcn_s_setprio(1); _Pragma("unroll") for (int m = 0; m < 4; ++m) _Pragma("unroll") for (int n = 0; n < 2; ++n) _Pragma("unroll") for (int k = 0; k < 2; ++k) \
        acc[ai][bj][m][n] = __builtin_amdgcn_mfma_f32_16x16x32_bf16(Bt[n][k], At[m][k], acc[ai][bj][m][n], 0, 0, 0); __builtin_amdgcn_s_setprio(0); } while (0)
#define PG8_WAIT_V(n) asm volatile("s_waitcnt vmcnt(" #n ")" ::: "memory")
#define PG8_WAIT_L(n) asm volatile("s_waitcnt lgkmcnt(" #n ")" ::: "memory")
#define PG8_BAR __builtin_amdgcn_s_barrier()
#define PG8_SCHED __builtin_amdgcn_sched_barrier(0)
  Unit cur, nxt; int ui = 0;
  if (!next_unit(p, gph, 0, cur)) return;
  f32x4 acc[2][2][4][2];
#pragma unroll
  for (int a = 0; a < 2; ++a)
#pragma unroll
    for (int b = 0; b < 2; ++b)
#pragma unroll
      for (int m = 0; m < 4; ++m)
#pragma unroll
        for (int n = 0; n < 2; ++n) acc[a][b][m][n] = (f32x4){0.f, 0.f, 0.f, 0.f};
  bf16x8 At[4][2], B0[2][2], B1[2][2];
  const char* cA = cur.A; const char* cB = cur.B;
  PG8_STAGE(PG8_SB(0, 0), cB); PG8_STAGE(PG8_SA(0, 0), cA); PG8_STAGE(PG8_SB(0, 1), cB + hstep); PG8_STAGE(PG8_SA(0, 1), cA + hstep);
  if (wr == 1) PG8_BAR;
  PG8_WAIT_V(4); PG8_BAR;
  PG8_STAGE(PG8_SB(1, 0), cB + kstep); PG8_STAGE(PG8_SA(1, 0), cA + kstep); PG8_STAGE(PG8_SB(1, 1), cB + hstep + kstep);
  PG8_WAIT_V(6); PG8_BAR;
  for (;;) {
    const bool has_next = next_unit(p, gph, ui + 1, nxt);
    const char* nA = has_next ? nxt.A : cA; const char* nB = has_next ? nxt.B : cB;
    const int nt = cur.nt;
    for (int t = 0; t < nt; t += 2) {
      const bool last = (t == nt - 2);
      const char* a1 = cA + (size_t)(t + 1) * kstep;
      const char* a2 = last ? nA : cA + (size_t)(t + 2) * kstep; const char* b2 = last ? nB : cB + (size_t)(t + 2) * kstep;
      const char* a3 = a2 + kstep; const char* b3 = b2 + kstep;
      PG8_LDB(B0, 0, 0); PG8_SCHED; PG8_LDA(At, 0, 0); PG8_STAGE(PG8_SA(1, 1), a1 + hstep);
      PG8_WAIT_L(8); PG8_BAR; PG8_WAIT_L(0); PG8_MMA(0, 0, At, B0); PG8_BAR; PG8_SCHED;
      PG8_LDB(B1, 0, 1); PG8_STAGE(PG8_SB(0, 0), b2);
      PG8_BAR; PG8_WAIT_L(0); PG8_MMA(0, 1, At, B1); PG8_BAR;
      PG8_LDA(At, 0, 1); PG8_STAGE(PG8_SA(0, 0), a2);
      PG8_BAR; PG8_WAIT_L(0); PG8_MMA(1, 0, At, B0); PG8_BAR; PG8_SCHED;
      PG8_STAGE(PG8_SB(0, 1), b2 + hstep);
      PG8_WAIT_V(6); PG8_BAR; PG8_MMA(1, 1, At, B1); PG8_BAR;
      PG8_LDB(B0, 1, 0); PG8_SCHED; PG8_LDA(At, 1, 0); PG8_STAGE(PG8_SA(0, 1), a2 + hstep);
      PG8_WAIT_L(8); PG8_BAR; PG8_WAIT_L(0); PG8_MMA(0, 0, At, B0); PG8_BAR; PG8_SCHED;
      PG8_LDB(B1, 1, 1); PG8_STAGE(PG8_SB(1, 0), b3);
      PG8_BAR; PG8_WAIT_L(0); PG8_MMA(0, 1, At, B1); PG8_BAR;
      PG8_LDA(At, 1, 1); PG8_STAGE(PG8_SA(1, 0), a3);
      PG8_BAR; PG8_WAIT_L(0); PG8_MMA(1, 0, At, B0); PG8_BAR; PG8_SCHED;
      PG8_STAGE(PG8_SB(1, 1), b3 + hstep);
      PG8_WAIT_V(6); PG8_BAR; PG8_MMA(1, 1, At, B1); PG8_BAR;
    }
    epilogue(p, cur, acc, wr, wc, fr, fq);
    if (!has_next) break;
#pragma unroll
    for (int a = 0; a < 2; ++a)
#pragma unroll
      for (int b = 0; b < 2; ++b)
#pragma unroll
        for (int m = 0; m < 4; ++m)
#pragma unroll
          for (int n = 0; n < 2; ++n) acc[a][b][m][n] = (f32x4){0.f, 0.f, 0.f, 0.f};
    cur = nxt; cA = nA; cB = nB; ++ui;
  }
  PG8_WAIT_V(0);
  if (wr == 0) PG8_BAR;
  PG8_BAR;
#undef PG8_SA
#undef PG8_SB
#undef PG8_STAGE
#undef PG8_LDA
#undef PG8_LDB
#undef PG8_MMA
#undef PG8_WAIT_V
#undef PG8_WAIT_L
#undef PG8_BAR
#undef PG8_SCHED
}

template <int NT> __device__ __forceinline__ void conv_tilesN(const Params& p, LAS unsigned char* lds, int tid, int t0, int stride, int t_end) {
  unsigned char* ws = p.ws;
  LAS float* tile = (LAS float*)lds;
  const int tx = tid & 63, ty = tid >> 6;
  {
    float v[NT][8];
#pragma unroll
    for (int q = 0; q < NT; ++q) {
      const int t = t0 + q * stride;
      if (t < t_end) {
        int mat, loc, ktn;
        if (t < 7680) { mat = 0; loc = t; ktn = 32; }
        else if (t < 9728) { mat = 1; loc = t - 7680; ktn = 64; }
        else if (t < 10752) { mat = 2; loc = t - 9728; ktn = 32; }
        else if (t < 16384) { mat = 3; loc = t - 10752; ktn = 32; }
        else if (t < 19200) { mat = 4; loc = t - 16384; ktn = 88; }
        else { mat = 5; loc = t - 19200; ktn = 32; }
        const int n0 = (loc / ktn) * 64, k0 = (loc % ktn) * 64;
        const int n = n0 + tx;
        const float* ptr; int ld, col, kk0 = k0;
        if (mat == 0) {
          ptr = p.in[6]; ld = INW; col = n;
          if (n >= OFF_RQ && n < OFF_RV) { const int s = n & 127; col = (n & ~127) + ((s >> 4) & 1) * 64 + (s >> 5) * 16 + (s & 15); }
        } else if (mat == 1) {
          ld = 2048; col = n;
          if (k0 < 1024) { ptr = p.in[11]; } else if (k0 < 3072) { ptr = p.in[13]; kk0 = k0 - 1024; } else { ptr = p.in[16]; kk0 = k0 - 3072; }
        } else if (mat == 2) { ptr = p.in[17]; ld = 2048; col = n; }
        else if (mat == 3) {
          const int T = n >> 8, s = n & 255;
          const int f = 128 * T + 64 * (s >> 7) + 16 * ((s >> 5) & 3) + (s & 15);
          ptr = ((s >> 4) & 1) ? p.in[21] : p.in[20]; ld = DFF; col = f;
        } else if (mat == 4) { ptr = p.in[22]; ld = 2048; col = n; }
        else { if (n < 1024) { ptr = p.in[14]; col = n; } else { ptr = p.in[15]; col = n - 1024; } ld = 1024; }
        const float* s0 = ptr + (size_t)(kk0 + ty * 8) * ld + col;
#pragma unroll
        for (int r = 0; r < 8; ++r) v[q][r] = __builtin_nontemporal_load(s0 + (size_t)r * ld);
      }
    }
#pragma unroll
    for (int q = 0; q < NT; ++q) {
      const int t = t0 + q * stride;
      if (t < t_end) {
        int loc, ktn, ldd; size_t dsto;
        if (t < 7680) { loc = t; ktn = 32; ldd = 2048; dsto = WS_WIN; }
        else if (t < 9728) { loc = t - 7680; ktn = 64; ldd = 4096; dsto = WS_WCAT; }
        else if (t < 10752) { loc = t - 9728; ktn = 32; ldd = 2048; dsto = WS_WOUT; }
        else if (t < 16384) { loc = t - 10752; ktn = 32; ldd = 2048; dsto = WS_WGU; }
        else if (t < 19200) { loc = t - 16384; ktn = 88; ldd = 5632; dsto = WS_WDN; }
        else { loc = t - 19200; ktn = 32; ldd = 2048; dsto = WS_WMKV; }
        const int n0 = (loc / ktn) * 64, k0 = (loc % ktn) * 64;
        __syncthreads();
#pragma unroll
        for (int r = 0; r < 8; ++r) tile[(ty * 8 + r) * 65 + tx] = v[q][r];
        __syncthreads();
        const int nn = tid >> 3, kc = (tid & 7) * 8;
        float w[8];
#pragma unroll
        for (int e = 0; e < 8; ++e) w[e] = tile[(kc + e) * 65 + nn];
        u32x4 o; o[0] = cvt_pk(w[0], w[1]); o[1] = cvt_pk(w[2], w[3]); o[2] = cvt_pk(w[4], w[5]); o[3] = cvt_pk(w[6], w[7]);
        *(u32x4*)((bf16_t*)(ws + dsto) + (size_t)(n0 + nn) * ldd + k0 + kc) = o;
      }
    }
  }
}

__device__ __forceinline__ void phase_prep(const Params& p, LAS unsigned char* lds) {
  int tid = threadIdx.x; asm volatile("" : "+v"(tid));
  unsigned char* ws = p.ws;
  if (blockIdx.x == 0 && tid < 16) { ((unsigned*)(ws + WS_CTL))[tid] = 0u; }
  {
    float* rope = (float*)(ws + WS_ROPE);
    for (int idx = blockIdx.x * 512 + tid; idx < 2056 * 64; idx += gridDim.x * 512) {
      const int pidx = idx >> 6, i = idx & 63;
      const double pos = pidx < 2048 ? (double)pidx : (double)(16384 + (pidx - 2048));
      double inv = 1.0; for (int k = 0; k < i; ++k) inv *= 0.8659643233600653;
      double rev = pos * inv * 0.15915494309189535;
      rev -= floor(rev);
      const float fr = (float)rev;
      rope[(size_t)idx * 2] = __builtin_amdgcn_cosf(fr);
      rope[(size_t)idx * 2 + 1] = __builtin_amdgcn_sinf(fr);
    }
  }
  {
    const int NCH_X = NTOK * DM / 8, NCH_M = 1024 * 2048 / 8, NCH = NCH_X + NCH_M;
    for (int ch0 = (blockIdx.x * 512 + tid); ch0 < NCH; ch0 += gridDim.x * 512 * 4) {
      f32x4 a[4], b[4];
#pragma unroll
      for (int q = 0; q < 4; ++q) {
        const int ch = ch0 + q * (int)gridDim.x * 512;
        if (ch < NCH) {
          const float* src = ch < TOKP * DM / 8 ? p.in[0] + (size_t)ch * 8 : ch < NCH_X ? p.in[1] + (size_t)(ch - TOKP * DM / 8) * 8 : p.in[2] + (size_t)(ch - NCH_X) * 8;
          a[q] = __builtin_nontemporal_load((const f32x4*)src); b[q] = __builtin_nontemporal_load((const f32x4*)(src + 4));
        }
      }
#pragma unroll
      for (int q = 0; q < 4; ++q) {
        const int ch = ch0 + q * (int)gridDim.x * 512;
        if (ch < NCH) {
          bf16_t* dst = ch < NCH_X ? (bf16_t*)(ws + WS_XB) + (size_t)ch * 8 : (bf16_t*)(ws + WS_MEMB) + (size_t)(ch - NCH_X) * 8;
          u32x4 o; o[0] = cvt_pk(a[q][0], a[q][1]); o[1] = cvt_pk(a[q][2], a[q][3]); o[2] = cvt_pk(b[q][0], b[q][1]); o[3] = cvt_pk(b[q][2], b[q][3]);
          *(u32x4*)dst = o;
        }
      }
    }
  }
  for (int tb = blockIdx.x; tb < 7680; tb += 8 * gridDim.x) conv_tilesN<8>(p, lds, tid, tb, (int)gridDim.x, 7680);
  for (int tb = 19200 + blockIdx.x; tb < 20224; tb += 4 * gridDim.x) conv_tilesN<4>(p, lds, tid, tb, (int)gridDim.x, 20224);
  __syncthreads();
}

__device__ __forceinline__ void conv_queue(const Params& p, LAS unsigned char* lds, unsigned* ctr, int t_begin, int t_end) {
  int tid = threadIdx.x; asm volatile("" : "+v"(tid));
  LAS unsigned* slot = (LAS unsigned*)(lds + LDS_CTL);
  unsigned nxt = 0u;
  if (tid == 0) nxt = atomicAdd(ctr, 4u);
  for (;;) {
    __syncthreads();
    if (tid == 0) *slot = nxt;
    __syncthreads();
    const int base = t_begin + (int)__builtin_amdgcn_readfirstlane(*slot);
    if (base >= t_end) break;
    if (tid == 0) nxt = atomicAdd(ctr, 4u);
    conv_tilesN<4>(p, lds, tid, base, 1, t_end);
  }
}

__device__ __forceinline__ float ret_lg(int h) { return log1pf(-exp2f(-5.0f - (float)h)); }

__device__ __forceinline__ void mix_ret_prompt(const Params& p, LAS unsigned char* lds, int u) {
  int tid = threadIdx.x; asm volatile("" : "+v"(tid)); const int w = tid >> 6, lane = tid & 63, fr = lane & 15, fq = lane >> 4;
  const int b = u >> 5, h = (u >> 2) & 7, es = u & 3;
  unsigned char* ws = p.ws;
  const bf16_t* RQ = (const bf16_t*)(ws + WS_RQ); const bf16_t* RK = (const bf16_t*)(ws + WS_RK); const bf16_t* RV = (const bf16_t*)(ws + WS_RV);
  bf16_t* RO = (bf16_t*)(ws + WS_RO);
  LAS unsigned char* Qi = lds;
  LAS unsigned char* Ki = lds + 34816;
  LAS unsigned char* Vi = lds + 69632;
  LAS unsigned char* Si = lds + 88064;
  const float lg = ret_lg(h);
  const float cd = __expf(128.0f * lg);
  const int irow = 16 * w + fr;
  const float sa = __expf((float)(irow - 127) * lg), sb = __expf((float)(irow + 1) * lg);
  f32x4 accS[4];
#pragma unroll
  for (int n = 0; n < 4; ++n) accS[n] = (f32x4){0.f, 0.f, 0.f, 0.f};
  u32x4 nq[4], nk[4], nv[2];
#pragma unroll
  for (int it = 0; it < 4; ++it) {
    const int ch = tid + it * 512, row = ch >> 4, cc = ch & 15;
    nq[it] = *(const u32x4*)(RQ + (size_t)(b * 2048 + row) * 1024 + h * 128 + cc * 8);
    nk[it] = *(const u32x4*)(RK + (size_t)(b * 2048 + row) * 1024 + h * 128 + cc * 8);
  }
#pragma unroll
  for (int it = 0; it < 2; ++it) {
    const int ch = tid + it * 512, row = ch >> 3, cc = ch & 7;
    nv[it] = *(const u32x4*)(RV + (size_t)(b * 2048 + row) * 2048 + h * 256 + es * 64 + cc * 8);
  }
  for (int c = 0; c < 16; ++c) {
    const int t0 = b * 2048 + c * 128;
    __syncthreads();
#pragma unroll
    for (int it = 0; it < 4; ++it) {
      const int ch = tid + it * 512, row = ch >> 4, cc = ch & 15;
      *(LAS u32x4*)(Qi + row * 272 + cc * 16) = nq[it];
      *(LAS u32x4*)(Ki + row * 272 + cc * 16) = nk[it];
    }
#pragma unroll
    for (int it = 0; it < 2; ++it) {
      const int ch = tid + it * 512, row = ch >> 3, cc = ch & 7;
      const u32x4 vv = nv[it];
      const float sc = __expf((float)(127 - row) * lg);
      u32x4 o;
#pragma unroll
      for (int e = 0; e < 4; ++e) o[e] = cvt_pk(bflo(vv[e]) * sc, bfhi(vv[e]) * sc);
      *(LAS u32x4*)(Vi + row * 144 + cc * 16) = o;
    }
#pragma unroll
    for (int n = 0; n < 4; ++n) *(LAS u32x2*)(Si + irow * 144 + (16 * n + 4 * fq) * 2) = pack4(accS[n]);
    if (c + 1 < 16) {
      const int t1 = t0 + 128;
#pragma unroll
      for (int it = 0; it < 4; ++it) {
        const int ch = tid + it * 512, row = ch >> 4, cc = ch & 15;
        nq[it] = *(const u32x4*)(RQ + (size_t)(t1 + row) * 1024 + h * 128 + cc * 8);
        nk[it] = *(const u32x4*)(RK + (size_t)(t1 + row) * 1024 + h * 128 + cc * 8);
      }
#pragma unroll
      for (int it = 0; it < 2; ++it) {
        const int ch = tid + it * 512, row = ch >> 3, cc = ch & 7;
        nv[it] = *(const u32x4*)(RV + (size_t)(t1 + row) * 2048 + h * 256 + es * 64 + cc * 8);
      }
    }
    __syncthreads();
    bf16x8 Qf[4];
#pragma unroll
    for (int ks = 0; ks < 4; ++ks) Qf[ks] = ldfrag(Qi, irow, 32 * ks + 8 * fq, 272);
    f32x4 sc8[8];
#pragma unroll
    for (int nt = 0; nt < 8; ++nt) {
      sc8[nt] = (f32x4){0.f, 0.f, 0.f, 0.f};
#pragma unroll
      for (int ks = 0; ks < 4; ++ks) sc8[nt] = MFMA16(ldfrag(Ki, 16 * nt + fr, 32 * ks + 8 * fq, 272), Qf[ks], sc8[nt]);
#pragma unroll
      for (int j = 0; j < 4; ++j) if (16 * nt + 4 * fq + j > irow) sc8[nt][j] = 0.f;
    }
    bf16x8 Pf[4];
#pragma unroll
    for (int k2 = 0; k2 < 4; ++k2) {
      const u32x2 lo = pack4(sc8[2 * k2]), hi = pack4(sc8[2 * k2 + 1]);
      const u32x4 t = (u32x4){lo[0], lo[1], hi[0], hi[1]};
      Pf[k2] = __builtin_bit_cast(bf16x8, t);
    }
    bf16x8 Vf[4][4];
#pragma unroll
    for (int n = 0; n < 4; ++n)
#pragma unroll
      for (int k2 = 0; k2 < 4; ++k2) Vf[n][k2] = ldfrag_tr(Vi, 32 * k2 + 4 * fq, 32 * k2 + 16 + 4 * fq, 16 * n, 144, lane);
#pragma unroll
    for (int n = 0; n < 4; ++n) {
      f32x4 aA = (f32x4){0.f, 0.f, 0.f, 0.f}, aB = (f32x4){0.f, 0.f, 0.f, 0.f};
#pragma unroll
      for (int k2 = 0; k2 < 4; ++k2) aA = MFMA16(Vf[n][k2], Pf[k2], aA);
#pragma unroll
      for (int ks = 0; ks < 4; ++ks) aB = MFMA16(ldfrag_tr(Si, 32 * ks + 8 * fq, 32 * ks + 8 * fq + 4, 16 * n, 144, lane), Qf[ks], aB);
      const f32x4 o = aA * sa + aB * sb;
      *(u32x2*)(RO + (size_t)(t0 + irow) * 2048 + h * 256 + es * 64 + 16 * n + 4 * fq) = pack4(o);
    }
    bf16x8 Kt[4];
#pragma unroll
    for (int k2 = 0; k2 < 4; ++k2) Kt[k2] = ldfrag_tr(Ki, 32 * k2 + 4 * fq, 32 * k2 + 16 + 4 * fq, 16 * w, 272, lane);
#pragma unroll
    for (int n = 0; n < 4; ++n) {
      accS[n] = accS[n] * cd;
#pragma unroll
      for (int k2 = 0; k2 < 4; ++k2) accS[n] = MFMA16(Vf[n][k2], Kt[k2], accS[n]);
    }
  }
  float* so = p.out + O_SRP + ((size_t)(b * 8 + h) * 128 + irow) * 256 + es * 64;
#pragma unroll
  for (int n = 0; n < 4; ++n) *(f32x4*)(so + 16 * n + 4 * fq) = accS[n];
}

__device__ __forceinline__ void mix_ret_sample(const Params& p, LAS unsigned char* lds, int u) {
  int tid = threadIdx.x; asm volatile("" : "+v"(tid)); const int w = tid >> 6, lane = tid & 63;
  const int b = u >> 3, h = u & 7;
  unsigned char* ws = p.ws;
  const bf16_t* RQ = (const bf16_t*)(ws + WS_RQ); const bf16_t* RK = (const bf16_t*)(ws + WS_RK); const bf16_t* RV = (const bf16_t*)(ws + WS_RV);
  const bf16_t* RG = (const bf16_t*)(ws + WS_RG);
  bf16_t* ACAT = (bf16_t*)(ws + WS_ACAT);
  LAS float* qT = (LAS float*)lds;
  LAS float* kT = (LAS float*)(lds + 4096);
  LAS float* scs = (LAS float*)(lds + 8192);
  LAS float* red = (LAS float*)(lds + 8704);
  const float lg = ret_lg(h);
  const int r0 = TOKP + 8 * b;
  f32x4 s0v[16];
  {
    const float* S0p = p.in[3] + ((size_t)(b * 8 + h) * 128 + 16 * w) * 256 + 4 * lane;
#pragma unroll
    for (int dd = 0; dd < 16; ++dd) s0v[dd] = __builtin_nontemporal_load((const f32x4*)(S0p + dd * 256));
  }
  __syncthreads();
  for (int idx = tid; idx < 1024; idx += 512) {
    const int i = idx >> 7, d = idx & 127;
    qT[d * 8 + i] = bflo((unsigned)RQ[(size_t)(r0 + i) * 1024 + h * 128 + d]);
    kT[d * 8 + i] = bflo((unsigned)RK[(size_t)(r0 + i) * 1024 + h * 128 + d]) * __expf((float)(7 - i) * lg);
  }
  const int e4 = 4 * lane;
  f32x4 vv[8];
#pragma unroll
  for (int j = 0; j < 8; ++j) vv[j] = unpack4(*(const u32x2*)(RV + (size_t)(r0 + j) * 2048 + h * 256 + e4));
  __syncthreads();
  if (tid < 64) {
    const int i = tid >> 3, j = tid & 7;
    float s = 0.f;
    for (int d = 0; d < 128; ++d) s += qT[d * 8 + i] * kT[d * 8 + j];
    scs[tid] = j <= i ? s * __expf((float)(i - 7) * lg) : 0.f;
  }
  const float cd = __expf(8.0f * lg);
  f32x4 acc[8];
#pragma unroll
  for (int i = 0; i < 8; ++i) acc[i] = (f32x4){0.f, 0.f, 0.f, 0.f};
  const float* S0 = p.in[3] + ((size_t)(b * 8 + h) * 128 + 16 * w) * 256 + e4;
  float* S1 = p.out + O_SRS + ((size_t)(b * 8 + h) * 128 + 16 * w) * 256 + e4;
#pragma unroll
  for (int dd = 0; dd < 16; ++dd) {
    const int d = 16 * w + dd;
    const f32x4 s0 = s0v[dd];
    const f32x4 qa = *(const LAS f32x4*)(qT + d * 8), qb = *(const LAS f32x4*)(qT + d * 8 + 4);
    const f32x4 ka = *(const LAS f32x4*)(kT + d * 8), kb = *(const LAS f32x4*)(kT + d * 8 + 4);
    acc[0] += s0 * qa[0]; acc[1] += s0 * qa[1]; acc[2] += s0 * qa[2]; acc[3] += s0 * qa[3];
    acc[4] += s0 * qb[0]; acc[5] += s0 * qb[1]; acc[6] += s0 * qb[2]; acc[7] += s0 * qb[3];
    f32x4 sn = s0 * cd;
    sn += vv[0] * ka[0]; sn += vv[1] * ka[1]; sn += vv[2] * ka[2]; sn += vv[3] * ka[3];
    sn += vv[4] * kb[0]; sn += vv[5] * kb[1]; sn += vv[6] * kb[2]; sn += vv[7] * kb[3];
    __builtin_nontemporal_store(sn, (f32x4*)(S1 + dd * 256));
  }
#pragma unroll
  for (int i = 0; i < 8; ++i) *(LAS f32x4*)(red + (w * 8 + i) * 256 + e4) = acc[i];
  __syncthreads();
  {
    const int i = w;
    f32x4 o = (f32x4){0.f, 0.f, 0.f, 0.f};
#pragma unroll
    for (int ww = 0; ww < 8; ++ww) o += *(const LAS f32x4*)(red + (ww * 8 + i) * 256 + e4);
    o = o * __expf((float)(i + 1) * lg);
#pragma unroll
    for (int j = 0; j < 8; ++j) o += vv[j] * scs[i * 8 + j];
    const float mean = wave_sum(o[0] + o[1] + o[2] + o[3]) * (1.0f / 256.0f);
    const f32x4 dlt = o - mean;
    const float var = wave_sum(dlt[0] * dlt[0] + dlt[1] * dlt[1] + dlt[2] * dlt[2] + dlt[3] * dlt[3]) * (1.0f / 256.0f);
    const float rstd = rsqrtf(var + LN_EPS);
    const f32x4 gn = *(const f32x4*)(p.in[12] + h * 256 + e4);
    const f32x4 sg = unpack4(*(const u32x2*)(RG + (size_t)(r0 + i) * 2048 + h * 256 + e4));
    const f32x4 r = dlt * rstd * gn * sg;
    *(u32x2*)(ACAT + (size_t)(r0 + i) * 4096 + 1024 + h * 256 + e4) = pack4(r);
  }
}

__device__ __forceinline__ void mix_sg_prompt(const Params& p, LAS unsigned char* lds, int u) {
  int tid = threadIdx.x; asm volatile("" : "+v"(tid)); const int w = tid >> 6, lane = tid & 63, fr = lane & 15, fq = lane >> 4;
  const int b = u >> 6, c = (u >> 2) & 15, g = u & 3;
  unsigned char* ws = p.ws;
  const bf16_t* VA = (const bf16_t*)(ws + WS_VA); const bf16_t* U = (const bf16_t*)(ws + WS_U);
  bf16_t* ACAT = (bf16_t*)(ws + WS_ACAT);
  LAS unsigned char* Vs = lds;
  LAS unsigned char* Wsm = lds + 67584;
  const int t0 = b * 2048 + c * 128;
  __syncthreads();
  {
    const int row = tid >> 2, part = tid & 3;
    const bf16_t* src = VA + (size_t)(t0 + row) * 1024 + g * 256;
    u32x4 raw[8];
#pragma unroll
    for (int k = 0; k < 8; ++k) raw[k] = *(const u32x4*)(src + (part + 4 * k) * 8);
    float s = 0.f;
#pragma unroll
    for (int k = 0; k < 8; ++k)
#pragma unroll
      for (int e = 0; e < 4; ++e) s += bflo(raw[k][e]) + bfhi(raw[k][e]);
    s += __shfl_xor(s, 1); s += __shfl_xor(s, 2);
    const float mean = s * (1.0f / 256.0f);
    float q = 0.f;
#pragma unroll
    for (int k = 0; k < 8; ++k)
#pragma unroll
      for (int e = 0; e < 4; ++e) { const float a = bflo(raw[k][e]) - mean, bb = bfhi(raw[k][e]) - mean; q += a * a + bb * bb; }
    q += __shfl_xor(q, 1); q += __shfl_xor(q, 2);
    const float rstd = rsqrtf(q * (1.0f / 256.0f) + LN_EPS);
    const float* lng = p.in[7] + g * 256; const float* lnb = p.in[8] + g * 256;
#pragma unroll
    for (int k = 0; k < 8; ++k) {
      const int col = (part + 4 * k) * 8;
      const f32x4 g0 = *(const f32x4*)(lng + col), g1 = *(const f32x4*)(lng + col + 4);
      const f32x4 b0 = *(const f32x4*)(lnb + col), b1 = *(const f32x4*)(lnb + col + 4);
      u32x4 o;
      o[0] = cvt_pk((bflo(raw[k][0]) - mean) * rstd * g0[0] + b0[0], (bfhi(raw[k][0]) - mean) * rstd * g0[1] + b0[1]);
      o[1] = cvt_pk((bflo(raw[k][1]) - mean) * rstd * g0[2] + b0[2], (bfhi(raw[k][1]) - mean) * rstd * g0[3] + b0[3]);
      o[2] = cvt_pk((bflo(raw[k][2]) - mean) * rstd * g1[0] + b1[0], (bfhi(raw[k][2]) - mean) * rstd * g1[1] + b1[1]);
      o[3] = cvt_pk((bflo(raw[k][3]) - mean) * rstd * g1[2] + b1[2], (bfhi(raw[k][3]) - mean) * rstd * g1[3] + b1[3]);
      *(LAS u32x4*)(Vs + row * 528 + col * 2) = o;
    }
    const float* wsrc = p.in[9] + ((size_t)g * 128 + row) * 128 + part * 32;
#pragma unroll
    for (int k = 0; k < 4; ++k) {
      const f32x4 a = *(const f32x4*)(wsrc + k * 8), bb = *(const f32x4*)(wsrc + k * 8 + 4);
      const int j0 = part * 32 + k * 8;
      float v[8] = {a[0], a[1], a[2], a[3], bb[0], bb[1], bb[2], bb[3]};
#pragma unroll
      for (int e = 0; e < 8; ++e) if (j0 + e > row) v[e] = 0.f;
      u32x4 o; o[0] = cvt_pk(v[0], v[1]); o[1] = cvt_pk(v[2], v[3]); o[2] = cvt_pk(v[4], v[5]); o[3] = cvt_pk(v[6], v[7]);
      *(LAS u32x4*)(Wsm + row * 272 + j0 * 2) = o;
    }
  }
  __syncthreads();
  const int irow = 16 * w + fr;
  f32x4 acc[16];
#pragma unroll
  for (int n = 0; n < 16; ++n) acc[n] = (f32x4){0.f, 0.f, 0.f, 0.f};
#pragma unroll
  for (int ks = 0; ks < 4; ++ks) {
    const bf16x8 Af = ldfrag(Wsm, irow, 32 * ks + 8 * fq, 272);
#pragma unroll
    for (int n = 0; n < 16; ++n) acc[n] = MFMA16(ldfrag_tr(Vs, 32 * ks + 8 * fq, 32 * ks + 8 * fq + 4, 16 * n, 528, lane), Af, acc[n]);
  }
  const float bias = p.in[10][g * 128 + irow];
#pragma unroll
  for (int n = 0; n < 16; ++n) {
    const int d = 16 * n + 4 * fq;
    const f32x4 uu = unpack4(*(const u32x2*)(U + (size_t)(t0 + irow) * 1024 + g * 256 + d));
    const f32x4 o = uu * (acc[n] + bias);
    *(u32x2*)(ACAT + (size_t)(t0 + irow) * 4096 + g * 256 + d) = pack4(o);
  }
}

__device__ __forceinline__ void mix_sg_sample(const Params& p, LAS unsigned char* lds, int b) {
  int tid = threadIdx.x; asm volatile("" : "+v"(tid)); const int w = tid >> 6, lane = tid & 63;
  unsigned char* ws = p.ws;
  const bf16_t* VA = (const bf16_t*)(ws + WS_VA); const bf16_t* U = (const bf16_t*)(ws + WS_U);
  bf16_t* ACAT = (bf16_t*)(ws + WS_ACAT);
  LAS float* vs = (LAS float*)lds;
  const int r0 = TOKP + 8 * b;
  __syncthreads();
#pragma unroll
  for (int g = 0; g < 4; ++g) {
    const int col = g * 256 + 4 * lane;
    const f32x4 x = unpack4(*(const u32x2*)(VA + (size_t)(r0 + w) * 1024 + col));
    const float mean = wave_sum(x[0] + x[1] + x[2] + x[3]) * (1.0f / 256.0f);
    const f32x4 d = x - mean;
    const float var = wave_sum(d[0] * d[0] + d[1] * d[1] + d[2] * d[2] + d[3] * d[3]) * (1.0f / 256.0f);
    const float rstd = rsqrtf(var + LN_EPS);
    const f32x4 gg = *(const f32x4*)(p.in[7] + col), bb = *(const f32x4*)(p.in[8] + col);
    const f32x4 va = d * rstd * gg + bb;
    *(f32x4*)(p.out + O_CV + (size_t)(b * 8 + w) * 1024 + col) = va;
    *(LAS f32x4*)(vs + w * 1024 + col) = va;
  }
  __syncthreads();
#pragma unroll
  for (int g = 0; g < 4; ++g) {
    const int col = g * 256 + 4 * lane;
    const float bias = p.in[10][g * 128 + w];
    f32x4 z = (f32x4){bias, bias, bias, bias};
    for (int j = 0; j <= w; ++j) {
      const float wv = p.in[9][((size_t)g * 128 + w) * 128 + j];
      z += *(const LAS f32x4*)(vs + j * 1024 + col) * wv;
    }
    const f32x4 uu = unpack4(*(const u32x2*)(U + (size_t)(r0 + w) * 1024 + col));
    *(u32x2*)(ACAT + (size_t)(r0 + w) * 4096 + col) = pack4(uu * z);
  }
}

__device__ __forceinline__ void mix_ma_prompt(const Params& p, LAS unsigned char* lds, int u) {
  int tid = threadIdx.x; asm volatile("" : "+v"(tid)); const int w = tid >> 6, lane = tid & 63, fr = lane & 15, fq = lane >> 4;
  const int b = u >> 6, h = (u >> 4) & 3, qt = u & 15;
  unsigned char* ws = p.ws;
  const bf16_t* MQ = (const bf16_t*)(ws + WS_MQ); const bf16_t* MK = (const bf16_t*)(ws + WS_MKB); const bf16_t* MV = (const bf16_t*)(ws + WS_MVB);
  bf16_t* ACAT = (bf16_t*)(ws + WS_ACAT);
  LAS unsigned char* KV = lds;
  const int irow = b * 2048 + qt * 128 + 16 * w + fr;
  __syncthreads();
#pragma unroll
  for (int it = 0; it < 16; ++it) {
    const int ch = tid + it * 512, row = ch >> 5, cc = ch & 31;
    *(LAS u32x4*)(KV + row * 528 + cc * 16) = *(const u32x4*)(MK + (size_t)(b * 256 + row) * 1024 + h * 256 + cc * 8);
  }
  bf16x8 Qf[8];
#pragma unroll
  for (int ks = 0; ks < 8; ++ks) Qf[ks] = *(const bf16x8*)(MQ + (size_t)irow * 1024 + h * 256 + 32 * ks + 8 * fq);
  __syncthreads();
  f32x4 s[16];
#pragma unroll
  for (int n = 0; n < 16; ++n) {
    s[n] = (f32x4){0.f, 0.f, 0.f, 0.f};
#pragma unroll
    for (int ks = 0; ks < 8; ++ks) s[n] = MFMA16(ldfrag(KV, 16 * n + fr, 32 * ks + 8 * fq, 528), Qf[ks], s[n]);
  }
  float mx = -3.0e38f;
#pragma unroll
  for (int n = 0; n < 16; ++n) mx = fmaxf(mx, fmaxf(fmaxf(s[n][0], s[n][1]), fmaxf(s[n][2], s[n][3])));
  mx = fmaxf(mx, __shfl_xor(mx, 16)); mx = fmaxf(mx, __shfl_xor(mx, 32));
  float sum = 0.f;
#pragma unroll
  for (int n = 0; n < 16; ++n)
#pragma unroll
    for (int j = 0; j < 4; ++j) { const float e = __expf(s[n][j] - mx); s[n][j] = e; sum += e; }
  sum += __shfl_xor(sum, 16); sum += __shfl_xor(sum, 32);
  const float inv = 1.0f / sum;
  bf16x8 Pf[8];
#pragma unroll
  for (int k2 = 0; k2 < 8; ++k2) {
    const u32x2 lo = pack4(s[2 * k2]), hi = pack4(s[2 * k2 + 1]);
    const u32x4 t = (u32x4){lo[0], lo[1], hi[0], hi[1]};
    Pf[k2] = __builtin_bit_cast(bf16x8, t);
  }
  __syncthreads();
#pragma unroll
  for (int it = 0; it < 16; ++it) {
    const int ch = tid + it * 512, row = ch >> 5, cc = ch & 31;
    *(LAS u32x4*)(KV + row * 528 + cc * 16) = *(const u32x4*)(MV + (size_t)(b * 256 + row) * 1024 + h * 256 + cc * 8);
  }
  __syncthreads();
#pragma unroll
  for (int n = 0; n < 16; ++n) {
    f32x4 o = (f32x4){0.f, 0.f, 0.f, 0.f};
#pragma unroll
    for (int k2 = 0; k2 < 8; ++k2) o = MFMA16(ldfrag_tr(KV, 32 * k2 + 4 * fq, 32 * k2 + 16 + 4 * fq, 16 * n, 528, lane), Pf[k2], o);
    *(u32x2*)(ACAT + (size_t)irow * 4096 + 3072 + h * 256 + 16 * n + 4 * fq) = pack4(o * inv);
  }
}

__device__ __forceinline__ void mix_ma_sample(const Params& p, LAS unsigned char* lds, int u) {
  int tid = threadIdx.x; asm volatile("" : "+v"(tid)); const int w = tid >> 6, lane = tid & 63, fr = lane & 15, fq = lane >> 4;
  const int b = u >> 2, h = u & 3;
  unsigned char* ws = p.ws;
  const bf16_t* MQ = (const bf16_t*)(ws + WS_MQ);
  bf16_t* ACAT = (bf16_t*)(ws + WS_ACAT);
  LAS unsigned char* KV = lds;
  LAS float* Sc = (LAS float*)(lds + 135168);
  LAS unsigned char* Pb = lds + 135168 + 8192;
  const int r0 = TOKP + 8 * b;
  const float* Kc = p.in[4] + ((size_t)b * 256 * 4 + h) * 256;
  const float* Vc = p.in[5] + ((size_t)b * 256 * 4 + h) * 256;
  __syncthreads();
  bf16x8 Qf[8];
#pragma unroll
  for (int ks = 0; ks < 8; ++ks) Qf[ks] = *(const bf16x8*)(MQ + (size_t)(r0 + (fr & 7)) * 1024 + h * 256 + 32 * ks + 8 * fq);
#pragma unroll 1
  for (int it0 = 0; it0 < 32; it0 += 16) {
    f32x4 t[16];
#pragma unroll
    for (int k = 0; k < 16; ++k) { const int ch = tid + (it0 + k) * 512, row = ch >> 6, cc = ch & 63; t[k] = __builtin_nontemporal_load((const f32x4*)(Kc + (size_t)row * 1024 + cc * 4)); }
#pragma unroll
    for (int k = 0; k < 16; ++k) { const int ch = tid + (it0 + k) * 512, row = ch >> 6, cc = ch & 63; *(LAS u32x2*)(KV + row * 528 + cc * 8) = pack4(t[k]); }
  }
  f32x4 tv[16];
#pragma unroll
  for (int k = 0; k < 16; ++k) { const int ch = tid + k * 512, row = ch >> 6, cc = ch & 63; tv[k] = __builtin_nontemporal_load((const f32x4*)(Vc + (size_t)row * 1024 + cc * 4)); }
  __syncthreads();
#pragma unroll
  for (int t2 = 0; t2 < 2; ++t2) {
    const int n = 2 * w + t2;
    f32x4 s = (f32x4){0.f, 0.f, 0.f, 0.f};
#pragma unroll
    for (int ks = 0; ks < 8; ++ks) s = MFMA16(ldfrag(KV, 16 * n + fr, 32 * ks + 8 * fq, 528), Qf[ks], s);
    if (fr < 8) *(LAS f32x4*)(Sc + fr * 256 + 16 * n + 4 * fq) = s;
  }
  __syncthreads();
#pragma unroll
  for (int k = 0; k < 16; ++k) { const int ch = tid + k * 512, row = ch >> 6, cc = ch & 63; *(LAS u32x2*)(KV + row * 528 + cc * 8) = pack4(tv[k]); }
  {
    f32x4 t[16];
#pragma unroll
    for (int k = 0; k < 16; ++k) { const int ch = tid + (16 + k) * 512, row = ch >> 6, cc = ch & 63; t[k] = __builtin_nontemporal_load((const f32x4*)(Vc + (size_t)row * 1024 + cc * 4)); }
    {
      f32x4 sv = *(const LAS f32x4*)(Sc + w * 256 + 4 * lane);
      const float mx = wave_max(fmaxf(fmaxf(sv[0], sv[1]), fmaxf(sv[2], sv[3])));
      sv[0] = __expf(sv[0] - mx); sv[1] = __expf(sv[1] - mx); sv[2] = __expf(sv[2] - mx); sv[3] = __expf(sv[3] - mx);
      const float inv = 1.0f / wave_sum(sv[0] + sv[1] + sv[2] + sv[3]);
      *(LAS u32x2*)(Pb + w * 528 + lane * 8) = pack4(sv * inv);
    }
#pragma unroll
    for (int k = 0; k < 16; ++k) { const int ch = tid + (16 + k) * 512, row = ch >> 6, cc = ch & 63; *(LAS u32x2*)(KV + row * 528 + cc * 8) = pack4(t[k]); }
  }
  __syncthreads();
#pragma unroll
  for (int t2 = 0; t2 < 2; ++t2) {
    const int n = 2 * w + t2;
    f32x4 o = (f32x4){0.f, 0.f, 0.f, 0.f};
#pragma unroll
    for (int ks = 0; ks < 8; ++ks) o = MFMA16(ldfrag_tr(KV, 32 * ks + 8 * fq, 32 * ks + 8 * fq + 4, 16 * n, 528, lane), ldfrag(Pb, fr, 32 * ks + 8 * fq, 528), o);
    if (fr < 8) *(u32x2*)(ACAT + (size_t)(r0 + fr) * 4096 + 3072 + h * 256 + 16 * n + 4 * fq) = pack4(o);
  }
}

__device__ __forceinline__ void phase_mixers(const Params& p, LAS unsigned char* lds, int rep) {
  unsigned* ctr = (unsigned*)(p.ws + WS_CTL) + rep;
  LAS unsigned* slot = (LAS unsigned*)(lds + LDS_CTL);
  unsigned nxt = 0u;
  if (threadIdx.x == 0) nxt = atomicAdd(ctr, 1u);
  for (;;) {
    __syncthreads();
    if (threadIdx.x == 0) *slot = nxt;
    __syncthreads();
    const int u = (int)__builtin_amdgcn_readfirstlane(*slot);
    if (u >= 2304) break;
    if (threadIdx.x == 0) nxt = atomicAdd(ctr, 1u);
    if (u < 128) mix_ret_prompt(p, lds, u);
    else {
      const int v = u - 128, g = v / 17, s = v % 17;
      if (s < 8) mix_ret_sample(p, lds, g * 8 + s);
      else if (s < 12) mix_ma_sample(p, lds, g * 4 + (s - 8));
      else if (s < 14) mix_ma_prompt(p, lds, g * 2 + (s - 12));
      else if (s < 16) mix_sg_prompt(p, lds, g * 2 + (s - 14));
      else mix_sg_sample(p, lds, g);
    }
  }
}

__device__ __forceinline__ void phase_retpost(const Params& p) {
  int tid = threadIdx.x; asm volatile("" : "+v"(tid));
  const int w = tid >> 6, lane = tid & 63;
  unsigned char* ws = p.ws;
  const bf16_t* RO = (const bf16_t*)(ws + WS_RO); const bf16_t* RG = (const bf16_t*)(ws + WS_RG);
  bf16_t* ACAT = (bf16_t*)(ws + WS_ACAT);
  for (int pr0 = (blockIdx.x * 8 + w) * 8; pr0 < TOKP * 8; pr0 += gridDim.x * 8 * 8) {
    u32x2 xr[8], sr[8];
#pragma unroll
    for (int q = 0; q < 8; ++q) {
      const int pr = pr0 + q, r = pr >> 3, h = pr & 7;
      const size_t o = (size_t)r * 2048 + h * 256 + 4 * lane;
      xr[q] = __builtin_nontemporal_load((const u32x2*)(RO + o));
      sr[q] = __builtin_nontemporal_load((const u32x2*)(RG + o));
    }
#pragma unroll
    for (int q = 0; q < 8; ++q) {
      const int pr = pr0 + q, r = pr >> 3, h = pr & 7;
      const f32x4 x = unpack4(xr[q]);
      const float mean = wave_sum(x[0] + x[1] + x[2] + x[3]) * (1.0f / 256.0f);
      const f32x4 d = x - mean;
      const float var = wave_sum(d[0] * d[0] + d[1] * d[1] + d[2] * d[2] + d[3] * d[3]) * (1.0f / 256.0f);
      const float rstd = rsqrtf(var + LN_EPS);
      const f32x4 gn = *(const f32x4*)(p.in[12] + h * 256 + 4 * lane);
      const f32x4 sg = unpack4(sr[q]);
      *(u32x2*)(ACAT + (size_t)r * 4096 + 1024 + h * 256 + 4 * lane) = pack4(d * rstd * gn * sg);
    }
  }
}

__device__ __forceinline__ void ln_load_row(const Params& p, const float* src, int which, int r, int lane, f32x4 (&x)[8]) {
  const float* part = (const float*)(p.ws + WS_PART);
  const float* s = src + (size_t)r * 2048;
  const float* rs = which == 0 ? (r < TOKP ? p.in[0] + (size_t)r * 2048 : p.in[1] + (size_t)(r - TOKP) * 2048) : (const float*)(p.ws + WS_X1) + (size_t)r * 2048;
  const int pm = r >> 8, gid = pm >> 3, fm = gid * 8, gsz = (36 - fm) < 8 ? (36 - fm) : 8;
#pragma unroll
  for (int k = 0; k < 8; ++k) {
    const int wg = gid * 64 + k * gsz + (pm - fm), off = wg % 36, xcd = wg / 36;
    if (off >= 32) {
      const int j = (off - 32) * 8 + xcd;
      f32x4 v = __builtin_nontemporal_load((const f32x4*)(rs + 256 * k + 4 * lane)) * ALPHA;
      const float* pp = part + (size_t)j * 8 * 65536 + (r & 255) * 256 + 4 * lane;
      f32x4 t[8];
#pragma unroll
      for (int q = 0; q < 8; ++q) t[q] = __builtin_nontemporal_load((const f32x4*)(pp + (size_t)q * 65536));
#pragma unroll
      for (int q = 0; q < 8; ++q) v += t[q];
      x[k] = v;
    } else x[k] = __builtin_nontemporal_load((const f32x4*)(s + 256 * k + 4 * lane));
  }
}
__device__ __forceinline__ void ln_finish_row(int r, int lane, f32x4 (&x)[8], float* dstf, bf16_t* dstb, const float* g, const float* bta) {
  float sm = 0.f;
#pragma unroll
  for (int k = 0; k < 8; ++k) sm += x[k][0] + x[k][1] + x[k][2] + x[k][3];
  const float mean = wave_sum(sm) * (1.0f / 2048.0f);
  float q = 0.f;
#pragma unroll
  for (int k = 0; k < 8; ++k) { x[k] = x[k] - mean; q += x[k][0] * x[k][0] + x[k][1] * x[k][1] + x[k][2] * x[k][2] + x[k][3] * x[k][3]; }
  const float rstd = rsqrtf(wave_sum(q) * (1.0f / 2048.0f) + LN_EPS);
#pragma unroll
  for (int k = 0; k < 8; ++k) {
    const int col = 256 * k + 4 * lane;
    const f32x4 gg = *(const f32x4*)(g + col), bb = *(const f32x4*)(bta + col);
    const f32x4 y = x[k] * rstd * gg + bb;
    *(f32x4*)(dstf + (size_t)r * 2048 + col) = y;
    if (dstb) *(u32x2*)(dstb + (size_t)r * 2048 + col) = pack4(y);
  }
}
__device__ __forceinline__ void phase_ln(const Params& p, const float* src, float* dstf, bf16_t* dstb, const float* g, const float* bta, int which) {
  int tid = threadIdx.x; asm volatile("" : "+v"(tid));
  const int w = tid >> 6, lane = tid & 63;
  const int nw = gridDim.x * 8;
  for (int r = blockIdx.x * 8 + w; r < NTOK; r += 2 * nw) {
    const int r2 = r + nw;
    f32x4 xa[8], xb[8];
    ln_load_row(p, src, which, r, lane, xa);
    if (r2 < NTOK) ln_load_row(p, src, which, r2, lane, xb);
    ln_finish_row(r, lane, xa, dstf, dstb, g, bta);
    if (r2 < NTOK) ln_finish_row(r2, lane, xb, dstf, dstb, g, bta);
  }
}

__device__ __forceinline__ void merge_split_reduce(const Params& p) {
  int tid = threadIdx.x; asm volatile("" : "+v"(tid));
  const int j = blockIdx.x >> 3, sl = blockIdx.x & 7;
  int pm, pn; static_tile(36, 8, 256 + j, pm, pn);
  const float* pt = (const float*)(p.ws + WS_PART) + (size_t)j * 8 * 65536 + sl * 8192;
  bf16_t* mb = (bf16_t*)(p.ws + WS_MERGEDB) + ((size_t)pm * 256 + sl * 32) * 2048 + pn * 256;
#pragma unroll
  for (int it = 0; it < 4; ++it) {
    const int e = (it * 512 + tid) * 4, rl = e >> 8, cl = e & 255;
    f32x4 t[8];
#pragma unroll
    for (int q = 0; q < 8; ++q) t[q] = __builtin_nontemporal_load((const f32x4*)(pt + (size_t)q * 65536 + e));
    f32x4 v = t[0];
#pragma unroll
    for (int q = 1; q < 8; ++q) v += t[q];
    *(u32x2*)(mb + (size_t)rl * 2048 + cl) = pack4(v);
  }
}

__device__ __forceinline__ void ffn_split_reduce(const Params& p) {
  int tid = threadIdx.x; asm volatile("" : "+v"(tid));
  bf16_t* act = (bf16_t*)(p.ws + WS_ACT);
  for (int wk = blockIdx.x; wk < 384; wk += gridDim.x) {
    const int t = wk >> 3, sl = wk & 7;
    int pm, pn; static_tile(36, 44, 1536 + t, pm, pn);
    const float* pt = (const float*)(p.ws + WS_PART) + (size_t)t * 4 * 65536 + sl * 8192;
#pragma unroll
    for (int it = 0; it < 2; ++it) {
      const int idx = it * 512 + tid, rl = idx >> 5, g5 = idx & 31;
      const int bj = g5 >> 4, wc = (g5 >> 2) & 3, lg = g5 & 3;
      const int cl = 128 * bj + 32 * wc + 4 * lg;
      f32x4 tg[4], tu[4];
#pragma unroll
      for (int q = 0; q < 4; ++q) { tg[q] = __builtin_nontemporal_load((const f32x4*)(pt + (size_t)q * 65536 + rl * 256 + cl)); tu[q] = __builtin_nontemporal_load((const f32x4*)(pt + (size_t)q * 65536 + rl * 256 + cl + 16)); }
      const f32x4 g = tg[0] + tg[1] + tg[2] + tg[3], uu = tu[0] + tu[1] + tu[2] + tu[3];
      f32x4 v; v[0] = siluf_(g[0]) * uu[0]; v[1] = siluf_(g[1]) * uu[1]; v[2] = siluf_(g[2]) * uu[2]; v[3] = siluf_(g[3]) * uu[3];
      *(u32x2*)(act + (size_t)(pm * 256 + sl * 32 + rl) * DFF + pn * 128 + 64 * bj + 16 * wc + 4 * lg) = pack4(v);
    }
  }
}

#define XB_TMO      128
#define XB_XCNT(j)  (256  + 64 * (j))
#define XB_XSUB(j)  (1280 + 64 * (j))
#define XB_XGEN(j)  (2304 + 64 * (j))
#define XB_TOP      3328
#define XB_TOPGEN   3392
#define XCD_BAR_WORDS 3456
#define XB_SPIN_CAP (1u << 18)
__device__ __forceinline__ unsigned xb_ld(unsigned* p)              { return __hip_atomic_load(p, __ATOMIC_RELAXED, __HIP_MEMORY_SCOPE_AGENT); }
__device__ __forceinline__ unsigned xb_add(unsigned* p, unsigned v) { return __hip_atomic_fetch_add(p, v, __ATOMIC_RELAXED, __HIP_MEMORY_SCOPE_AGENT); }
__device__ __forceinline__ unsigned xb_xcc_id() { return (unsigned)__builtin_amdgcn_s_getreg((3 << 11) | 20) & 0xFu; }
#define XB_SPIN(cond, bar) do { unsigned _sp = 0; while (cond) { __builtin_amdgcn_s_sleep(1); \
    if ((++_sp & 255u) == 0u) { if (xb_ld(&(bar)[XB_TMO])) break; if (_sp > XB_SPIN_CAP) { atomicAdd(&(bar)[XB_TMO], 1u); break; } } } } while (0)
struct XcdBarrier { unsigned* bar; unsigned x; volatile LAS unsigned* st; };
__device__ __forceinline__ XcdBarrier xcd_barrier_post(unsigned* bar, volatile LAS unsigned* st) {
    XcdBarrier b; b.bar = bar; b.x = xb_xcc_id(); b.st = st;
    if (threadIdx.x == 0) (void)xb_add(&bar[XB_XCNT(b.x)], 1u);
    return b;
}
__device__ __forceinline__ void xcd_barrier_complete(unsigned* bar, unsigned x, unsigned& nloc, unsigned& nx) {
    const unsigned G = gridDim.x * gridDim.y * gridDim.z;
    unsigned sum, cnt, mine, sp = 0u;
    for (;;) {
        sum = 0u; cnt = 0u; mine = 0u;
#pragma unroll
        for (unsigned j = 0; j < 16; ++j) { const unsigned c = xb_ld(&bar[XB_XCNT(j)]); sum += c; cnt += (c > 0u) ? 1u : 0u; mine = (j == x) ? c : mine; }
        if (sum == G) break;
        __builtin_amdgcn_s_sleep(1);
        if ((++sp & 255u) == 0u) { if (xb_ld(&bar[XB_TMO])) break; if (sp > XB_SPIN_CAP) { atomicAdd(&bar[XB_TMO], 1u); break; } }
    }
    nloc = mine > 0u ? mine : 1u; nx = cnt > 0u ? cnt : 1u;
}
__device__ __forceinline__ void xcd_barrier(const XcdBarrier& b) {
    asm volatile("s_waitcnt vmcnt(0)" ::: "memory");
    __syncthreads();
    if (threadIdx.x == 0) {
        unsigned* bar = b.bar;
        __builtin_amdgcn_s_waitcnt(0);
        unsigned nloc = b.st[0], nx = b.st[1];
        if (nloc == 0u) { xcd_barrier_complete(bar, b.x, nloc, nx); b.st[0] = nloc; b.st[1] = nx; }
        const unsigned old = xb_add(&bar[XB_XSUB(b.x)], 1u);
        const unsigned gen = old / nloc;
        if (old + 1u == (gen + 1u) * nloc) {
            __builtin_amdgcn_fence(__ATOMIC_RELEASE, "agent");
            asm volatile("s_waitcnt vmcnt(0)" ::: "memory");
            const unsigned og = xb_add(&bar[XB_TOP], 1u);
            const unsigned tg = og / nx;
            if (og + 1u == (tg + 1u) * nx) xb_add(&bar[XB_TOPGEN], 1u);
            else XB_SPIN(xb_ld(&bar[XB_TOPGEN]) == tg, bar);
            __builtin_amdgcn_fence(__ATOMIC_ACQUIRE, "agent");
            xb_add(&bar[XB_XGEN(b.x)], 1u);
            asm volatile("s_waitcnt vmcnt(0)" ::: "memory");
        } else {
            XB_SPIN(xb_ld(&bar[XB_XGEN(b.x)]) == gen, bar);
            __builtin_amdgcn_fence(__ATOMIC_ACQUIRE, "agent");
            asm volatile("s_waitcnt vmcnt(0)" ::: "memory");
        }
    }
    __syncthreads();
}

__global__ void __launch_bounds__(512, 2) fwd_megakernel(Params p) {
  extern __shared__ __attribute__((aligned(16))) unsigned char shm[];
  LAS unsigned char* lds = (LAS unsigned char*)shm;
  cg::grid_group grid = cg::this_grid();
  unsigned char* ws = p.ws;
  if (p.ph_hi > 1000) grid.sync();
  volatile LAS unsigned* xst = (volatile LAS unsigned*)(lds + LDS_CTL - 16);
  if (threadIdx.x == 0) { xst[0] = 0u; xst[1] = 0u; }
  __syncthreads();
  const XcdBarrier xb = xcd_barrier_post((unsigned*)(ws + WS_BAR), xst);
#ifndef PROBE_PH
#define PROBE_PH -1
#endif
  for (int ph = p.ph_lo; ph < p.ph_hi; ++ph) {
   for (int rep = 0; rep < (ph == PROBE_PH ? 2 : 1); ++rep) {
    if (rep) xcd_barrier(xb);
    if (ph == 1 || ph == 4 || ph == 5 || ph == 7 || ph == 8) {
      const int gph = ph == 1 ? 0 : ph == 4 ? 1 : ph == 5 ? 2 : ph == 7 ? 3 : 4;
      const unsigned ldB = gph == 1 ? 4096u * 2u : gph == 4 ? 5632u * 2u : 2048u * 2u;
      gemm_phase(p, lds, gph, ldB);
      if (gph == 0) conv_queue(p, lds, (unsigned*)(ws + WS_CTL) + 4, 7680, 16384);
      if (gph == 3) conv_queue(p, lds, (unsigned*)(ws + WS_CTL) + 5, 16384, 19200);
      if (gph == 1 && gridDim.x == 256) { xcd_barrier(xb); merge_split_reduce(p); }
      if (gph == 3 && gridDim.x == 256) { xcd_barrier(xb); ffn_split_reduce(p); }
    } else if (ph == 0) phase_prep(p, lds);
    else if (ph == 2) phase_mixers(p, lds, rep);
    else if (ph == 3) phase_retpost(p);
    else if (ph == 6) phase_ln(p, (const float*)(ws + WS_X1), (float*)(ws + WS_X1), (bf16_t*)(ws + WS_X1B), p.in[18], p.in[19], 0);
    else phase_ln(p, (const float*)(ws + WS_YPRE), p.out + O_Y, nullptr, p.in[23], p.in[24], 1);
   }
    if (ph + 1 < p.ph_hi) xcd_barrier(xb);
  }
}

extern "C" void kernel_launch(void* const* d_in, const int* in_sizes, int n_in, void* d_out, int out_size, void* d_ws, size_t ws_size, hipStream_t stream) {
  static int grid_blocks = 0;
  if (grid_blocks == 0) {
    if (n_in != 25 || ws_size < WS_END) { fprintf(stderr, "kernel_launch: unexpected n_in %d or ws_size %zu (need %zu)\n", n_in, ws_size, (size_t)WS_END); grid_blocks = -1; return; }
    int dev = 0, cus = 0, per_cu = 0;
    hipGetDevice(&dev);
    hipDeviceGetAttribute(&cus, hipDeviceAttributeMultiprocessorCount, dev);
    hipFuncSetAttribute((const void*)fwd_megakernel, hipFuncAttributeMaxDynamicSharedMemorySize, LDS_BYTES);
    hipOccupancyMaxActiveBlocksPerMultiprocessor(&per_cu, (const void*)fwd_megakernel, 512, LDS_BYTES);
    if (per_cu < 1) { fprintf(stderr, "kernel_launch: occupancy query returned %d\n", per_cu); per_cu = 1; }
    grid_blocks = cus * per_cu;
    (void)hipGetLastError();
  }
  if (grid_blocks < 0) return;
  if (hipMemsetAsync((char*)d_ws + WS_CTL, 0, WS_CTL_BYTES, stream) != hipSuccess) { fprintf(stderr, "kernel_launch: memset of control words failed\n"); return; }
  Params p{};
  for (int i = 0; i < 25; ++i) p.in[i] = (const float*)d_in[i];
  p.out = (float*)d_out; p.ws = (unsigned char*)d_ws; p.ph_lo = 0; p.ph_hi = 10;
  void* args[] = {&p};
  hipError_t e = hipLaunchCooperativeKernel((const void*)fwd_megakernel, dim3(grid_blocks), dim3(512), args, LDS_BYTES, stream);
  if (e != hipSuccess) fprintf(stderr, "cooperative launch failed: %s (grid %d)\n", hipGetErrorString(e), grid_blocks);
}
```

```cpp
#include <hip/hip_runtime.h>
#include <hip/hip_cooperative_groups.h>
#include <cstdio>
namespace cg = cooperative_groups;

#define LAS __attribute__((address_space(3)))
typedef unsigned short bf16_t;
typedef short bf16x8 __attribute__((ext_vector_type(8)));
typedef short s16x4 __attribute__((ext_vector_type(4)));
typedef float f32x4 __attribute__((ext_vector_type(4)));
typedef unsigned u32x2 __attribute__((ext_vector_type(2)));
typedef unsigned u32x4 __attribute__((ext_vector_type(4)));

constexpr int DM = 2048, NTOK = 9216, TOKP = 8192, INW = 15360, DFF = 5632;
constexpr int OFF_AU = 6144, OFF_AV = 7168, OFF_RQ = 8192, OFF_RK = 9216, OFF_RV = 10240, OFF_RG = 12288, OFF_MQ = 14336;
constexpr float ALPHA = 1.189207115002721f;
constexpr float LN_EPS = 1e-5f;

constexpr size_t al256(size_t x) { return (x + 255) & ~(size_t)255; }
constexpr size_t WS_CTL = 0;
constexpr size_t WS_BAR = 4096;
constexpr size_t WS_CTL_BYTES = 32768;
constexpr size_t WS_ROPE = 32768;
constexpr size_t WS_XB = al256(WS_ROPE + 2056ull * 64 * 2 * 4);
constexpr size_t WS_WIN = WS_XB + (size_t)NTOK * DM * 2;
constexpr size_t WS_WCAT = WS_WIN + (size_t)INW * DM * 2;
constexpr size_t WS_WOUT = WS_WCAT + 2048ull * 4096 * 2;
constexpr size_t WS_WGU = WS_WOUT + 2048ull * 2048 * 2;
constexpr size_t WS_WDN = WS_WGU + 11264ull * 2048 * 2;
constexpr size_t WS_WMKV = WS_WDN + 2048ull * 5632 * 2;
constexpr size_t WS_MEMB = WS_WMKV + 2048ull * 2048 * 2;
constexpr size_t WS_GATES = WS_MEMB + 1024ull * 2048 * 2;
constexpr size_t WS_U = WS_GATES + (size_t)NTOK * 6144 * 2;
constexpr size_t WS_VA = WS_U + (size_t)NTOK * 1024 * 2;
constexpr size_t WS_RQ = WS_VA + (size_t)NTOK * 1024 * 2;
constexpr size_t WS_RK = WS_RQ + (size_t)NTOK * 1024 * 2;
constexpr size_t WS_RV = WS_RK + (size_t)NTOK * 1024 * 2;
constexpr size_t WS_RG = WS_RV + (size_t)NTOK * 2048 * 2;
constexpr size_t WS_MQ = WS_RG + (size_t)NTOK * 2048 * 2;
constexpr size_t WS_MKB = WS_MQ + (size_t)NTOK * 1024 * 2;
constexpr size_t WS_MVB = WS_MKB + 1024ull * 1024 * 2;
constexpr size_t WS_RO = WS_MVB + 1024ull * 1024 * 2;
constexpr size_t WS_PART = WS_RO + 8192ull * 2048 * 2;
constexpr size_t WS_END = WS_PART + 256ull * 65536 * 4;
constexpr size_t WS_ACAT = WS_XB;
constexpr size_t WS_MERGED = WS_U;
constexpr size_t WS_MERGEDB = WS_RV;
constexpr size_t WS_X1 = WS_ACAT;
constexpr size_t WS_X1B = WS_RG;
constexpr size_t WS_ACT = WS_GATES;
constexpr size_t WS_YPRE = WS_MERGED;

constexpr size_t O_Y = 0, O_SRP = 18874368, O_MK = 19922944, O_MV = 20971520, O_SRS = 22020096, O_CV = 55574528;

constexpr int LDS_BYTES = 155648;
constexpr int LDS_CTL = 155632;

struct Params {
  const float* in[25];
  float* out;
  unsigned char* ws;
  int ph_lo, ph_hi;
};

typedef float f32x2 __attribute__((ext_vector_type(2)));
typedef __bf16 bf16x2_t __attribute__((ext_vector_type(2)));
__device__ __forceinline__ unsigned cvt_pk(float lo, float hi) { const f32x2 v = {lo, hi}; const bf16x2_t b = __builtin_convertvector(v, bf16x2_t); return __builtin_bit_cast(unsigned, b); }
__device__ __forceinline__ float bflo(unsigned u) { return __uint_as_float(u << 16); }
__device__ __forceinline__ float bfhi(unsigned u) { return __uint_as_float(u & 0xffff0000u); }
__device__ __forceinline__ u32x2 pack4(f32x4 v) { u32x2 r; r[0] = cvt_pk(v[0], v[1]); r[1] = cvt_pk(v[2], v[3]); return r; }
__device__ __forceinline__ f32x4 unpack4(u32x2 u) { f32x4 r; r[0] = bflo(u[0]); r[1] = bfhi(u[0]); r[2] = bflo(u[1]); r[3] = bfhi(u[1]); return r; }
__device__ __forceinline__ float sigmoidf_(float x) { return __builtin_amdgcn_rcpf(1.0f + __expf(-x)); }
__device__ __forceinline__ float gelu_tanh(float x) { const float z = 1.5957691216057308f * (x + 0.044715f * x * x * x); return x * sigmoidf_(z); }
__device__ __forceinline__ float siluf_(float x) { return x * sigmoidf_(x); }
__device__ __forceinline__ float wave_sum(float v) {
#pragma unroll
  for (int o = 32; o >= 1; o >>= 1) v += __shfl_xor(v, o);
  return v;
}
__device__ __forceinline__ float wave_max(float v) {
#pragma unroll
  for (int o = 32; o >= 1; o >>= 1) v = fmaxf(v, __shfl_xor(v, o));
  return v;
}
typedef short v4i16_t __attribute__((ext_vector_type(4)));
__device__ __forceinline__ s16x4 vtr(const LAS unsigned char* p) { return __builtin_bit_cast(s16x4, __builtin_amdgcn_ds_read_tr16_b64_v4i16((LAS v4i16_t*)p)); }
__device__ __forceinline__ bf16x8 ldfrag(const LAS unsigned char* img, int row, int k, int strideB) { return *(const LAS bf16x8*)(img + row * strideB + k * 2); }
__device__ __forceinline__ bf16x8 ldfrag_tr(const LAS unsigned char* img, int kr0, int kr1, int n0, int strideB, int lane) {
  const int i = lane & 15;
  const LAS unsigned char* a0 = img + (kr0 + (i >> 2)) * strideB + (n0 + 4 * (i & 3)) * 2;
  const LAS unsigned char* a1 = img + (kr1 + (i >> 2)) * strideB + (n0 + 4 * (i & 3)) * 2;
  const s16x4 lo = vtr(a0), hi = vtr(a1);
  return (bf16x8){lo[0], lo[1], lo[2], lo[3], hi[0], hi[1], hi[2], hi[3]};
}
#define MFMA16(a, b, c) __builtin_amdgcn_mfma_f32_16x16x32_bf16((a), (b), (c), 0, 0, 0)

constexpr int BM = 256, BK = 64, HALF = 128, HTB = HALF * BK * 2;
__device__ __forceinline__ int lds_byte(int r, int c) { const int st = (r >> 4) * 2 + (c >> 5), rr = r & 15, cc = c & 31, ob = rr * 64 + cc * 2; return st * 1024 + (ob ^ (((ob >> 9) & 1) << 5)); }
__device__ __forceinline__ void stage_rc(int b, int& R, int& C) { const int st = b / 1024, sb = b % 1024, swz = sb ^ (((sb >> 9) & 1) << 5); R = (st >> 1) * 16 + swz / 64; C = (st & 1) * 32 + (swz % 64) / 2; }

struct Unit { const char* A; const char* B; int nt, pm, pn, kind; };

__device__ __forceinline__ void static_tile(int nM, int nN, int L, int& pm, int& pn) {
  const int nwg = nM * nN; int wgid = L;
  { const int q = nwg / 8, r = nwg % 8, xcd = wgid % 8, off = wgid / 8; wgid = (xcd < r ? xcd * (q + 1) : r * (q + 1) + (xcd - r) * q) + off; }
  const int nig = 8 * nN, gid = wgid / nig, fm = gid * 8, gsz = (nM - fm) < 8 ? (nM - fm) : 8;
  pm = fm + ((wgid % nig) % gsz); pn = (wgid % nig) / gsz;
}

__device__ __forceinline__ bool next_unit(const Params& p, int gph, int i, Unit& u) {
  const int G = gridDim.x, c = blockIdx.x;
  const char* ws = (const char*)p.ws;
  if (gph == 0) {
    const int L = i * G + c;
    if (L < 2160) {
      static_tile(36, 60, L, u.pm, u.pn);
      u.A = ws + WS_XB + (size_t)u.pm * 256 * 2048 * 2; u.B = ws + WS_WIN + (size_t)u.pn * 256 * 2048 * 2; u.nt = 32;
      const int pn = u.pn;
      u.kind = pn < 24 ? 0 : pn < 28 ? 1 : pn < 32 ? 2 : pn < 36 ? 3 : pn < 40 ? 4 : pn < 48 ? 5 : pn < 56 ? 6 : 7;
      return true;
    }
    if (L < 2192) {
      const int mk = L - 2160; u.pm = mk >> 3; u.pn = mk & 7;
      u.A = ws + WS_MEMB + (size_t)u.pm * 256 * 2048 * 2; u.B = ws + WS_WMKV + (size_t)u.pn * 256 * 2048 * 2; u.nt = 32; u.kind = 8;
      return true;
    }
    return false;
  } else if (gph == 1) {
    if (G == 256 && i >= 3) {
      if (i > 3) return false;
      const int su = c, part = su & 7; int pm, pn;
      static_tile(36, 8, 256 + (su >> 3), pm, pn);
      const int seg = part < 2 ? 0 : part < 6 ? 1 : 2;
      const size_t ko = part * 512;
      u.A = ws + WS_ACAT + ((size_t)pm * 256 * 4096 + ko) * 2; u.B = ws + WS_WCAT + ((size_t)pn * 256 * 4096 + ko) * 2;
      u.nt = 8; u.kind = 17 + seg; u.pm = su; u.pn = pm * 8 + pn;
      return true;
    }
    const int L = (i / 3) * G + c, seg = i % 3;
    if (L >= (G == 256 ? 256 : 288)) return false;
    static_tile(36, 8, L, u.pm, u.pn);
    const size_t so = seg == 0 ? 0 : seg == 1 ? 1024 : 3072;
    u.A = ws + WS_ACAT + ((size_t)u.pm * 256 * 4096 + so) * 2; u.B = ws + WS_WCAT + ((size_t)u.pn * 256 * 4096 + so) * 2;
    u.nt = seg == 1 ? 32 : 16; u.kind = 9 + seg;
    return true;
  } else if (gph == 2) {
    const int v = i * G + c; if (v >= 512) return false;
    if (v < 256) {
      static_tile(36, 8, v, u.pm, u.pn);
      u.A = ws + WS_MERGEDB + (size_t)u.pm * 256 * 2048 * 2; u.B = ws + WS_WOUT + (size_t)u.pn * 256 * 2048 * 2; u.nt = 32; u.kind = 12;
    } else {
      const int su = v - 256, s = su & 7; int pm, pn;
      static_tile(36, 8, 256 + (su >> 3), pm, pn);
      u.A = ws + WS_MERGEDB + ((size_t)pm * 256 * 2048 + s * 256) * 2; u.B = ws + WS_WOUT + ((size_t)pn * 256 * 2048 + s * 256) * 2; u.nt = 4; u.kind = 16;
      u.pm = su; u.pn = 0;
    }
    return true;
  } else if (gph == 3) {
    const int L = i * G + c;
    if (G == 256 && L >= 1536) {
      const int su = L - 1536; if (su >= 192) return false;
      int pm, pn; static_tile(36, 44, 1536 + (su >> 2), pm, pn);
      const size_t ko = (size_t)(su & 3) * 512;
      u.A = ws + WS_X1B + ((size_t)pm * 256 * 2048 + ko) * 2; u.B = ws + WS_WGU + ((size_t)pn * 256 * 2048 + ko) * 2; u.nt = 8; u.kind = 16;
      u.pm = su; u.pn = 0;
      return true;
    }
    if (L >= 1584) return false;
    static_tile(36, 44, L, u.pm, u.pn);
    u.A = ws + WS_X1B + (size_t)u.pm * 256 * 2048 * 2; u.B = ws + WS_WGU + (size_t)u.pn * 256 * 2048 * 2; u.nt = 32; u.kind = 13;
    return true;
  } else {
    const int v = i * G + c; if (v >= 512) return false;
    if (v < 256) {
      static_tile(36, 8, v, u.pm, u.pn);
      u.A = ws + WS_ACT + (size_t)u.pm * 256 * 5632 * 2; u.B = ws + WS_WDN + (size_t)u.pn * 256 * 5632 * 2; u.nt = 88; u.kind = 14;
    } else {
      const int su = v - 256, s = su & 7; int pm, pn;
      static_tile(36, 8, 256 + (su >> 3), pm, pn);
      const int kt0 = s < 4 ? 12 * s : 48 + 10 * (s - 4);
      u.A = ws + WS_ACT + ((size_t)pm * 256 * 5632 + kt0 * 64) * 2; u.B = ws + WS_WDN + ((size_t)pn * 256 * 5632 + kt0 * 64) * 2; u.nt = s < 4 ? 12 : 10; u.kind = 16;
      u.pm = su; u.pn = 0;
    }
    return true;
  }
}

__device__ __forceinline__ void epilogue(const Params& p, const Unit& u, const f32x4 (&acc)[2][2][4][2], int wr, int wc, int fr, int fq) {
  unsigned char* ws = p.ws;
  const int row0 = u.pm * 256 + wr * 64 + fr;
  const int ct0 = wc * 32 + 4 * fq;
  const int kind = u.kind;
  if (kind <= 2 || (kind >= 5 && kind <= 7)) {
    bf16_t* dst; int ld, cb, act; float scale = 1.0f;
    if (kind == 0) { dst = (bf16_t*)(ws + WS_GATES); ld = 6144; cb = u.pn * 256; act = 1; }
    else if (kind == 1) { dst = (bf16_t*)(ws + WS_U); ld = 1024; cb = u.pn * 256 - OFF_AU; act = 2; }
    else if (kind == 2) { dst = (bf16_t*)(ws + WS_VA); ld = 1024; cb = u.pn * 256 - OFF_AV; act = 2; }
    else if (kind == 5) { dst = (bf16_t*)(ws + WS_RV); ld = 2048; cb = u.pn * 256 - OFF_RV; act = 0; }
    else if (kind == 6) { dst = (bf16_t*)(ws + WS_RG); ld = 2048; cb = u.pn * 256 - OFF_RG; act = 3; }
    else { dst = (bf16_t*)(ws + WS_MQ); ld = 1024; cb = u.pn * 256 - OFF_MQ; act = 0; scale = 0.0625f; }
#pragma unroll
    for (int ai = 0; ai < 2; ++ai)
#pragma unroll
      for (int m = 0; m < 4; ++m) {
        bf16_t* rp = dst + (size_t)(row0 + ai * 128 + m * 16) * ld + cb + ct0;
#pragma unroll
        for (int bj = 0; bj < 2; ++bj)
#pragma unroll
          for (int n = 0; n < 2; ++n) {
            f32x4 v = acc[ai][bj][m][n];
            if (act == 1) { v[0] = sigmoidf_(v[0]); v[1] = sigmoidf_(v[1]); v[2] = sigmoidf_(v[2]); v[3] = sigmoidf_(v[3]); }
            else if (act == 2) { v[0] = gelu_tanh(v[0]); v[1] = gelu_tanh(v[1]); v[2] = gelu_tanh(v[2]); v[3] = gelu_tanh(v[3]); }
            else if (act == 3) { v[0] = siluf_(v[0]); v[1] = siluf_(v[1]); v[2] = siluf_(v[2]); v[3] = siluf_(v[3]); }
            else { v = v * scale; }
            *(u32x2*)(rp + bj * 128 + n * 16) = pack4(v);
          }
      }
  } else if (kind == 3 || kind == 4) {
    bf16_t* dst = (bf16_t*)(ws + (kind == 3 ? WS_RQ : WS_RK));
    const float scale = kind == 3 ? 1.0f : 0.08838834764831845f;
    const int hb = (u.pn - (kind == 3 ? 32 : 36)) * 2;
    const float* rope = (const float*)(ws + WS_ROPE);
    const int ii = 16 * wc + 4 * fq;
#pragma unroll
    for (int ai = 0; ai < 2; ++ai) {
      f32x4 cs[4][2];
#pragma unroll
      for (int m = 0; m < 4; ++m) {
        const int row = row0 + ai * 128 + m * 16;
        const int pidx = row < TOKP ? (row & 2047) : 2048 + ((row - TOKP) & 7);
        cs[m][0] = *(const f32x4*)(rope + ((size_t)pidx * 64 + ii) * 2);
        cs[m][1] = *(const f32x4*)(rope + ((size_t)pidx * 64 + ii) * 2 + 4);
      }
#pragma unroll
      for (int m = 0; m < 4; ++m) {
        const int row = row0 + ai * 128 + m * 16;
        const f32x4 cs0 = cs[m][0], cs1 = cs[m][1];
#pragma unroll
        for (int bj = 0; bj < 2; ++bj) {
          const f32x4 x1 = acc[ai][bj][m][0] * scale, x2 = acc[ai][bj][m][1] * scale;
          f32x4 o1, o2;
          o1[0] = x1[0] * cs0[0] - x2[0] * cs0[1]; o2[0] = x1[0] * cs0[1] + x2[0] * cs0[0];
          o1[1] = x1[1] * cs0[2] - x2[1] * cs0[3]; o2[1] = x1[1] * cs0[3] + x2[1] * cs0[2];
          o1[2] = x1[2] * cs1[0] - x2[2] * cs1[1]; o2[2] = x1[2] * cs1[1] + x2[2] * cs1[0];
          o1[3] = x1[3] * cs1[2] - x2[3] * cs1[3]; o2[3] = x1[3] * cs1[3] + x2[3] * cs1[2];
          bf16_t* rp = dst + (size_t)row * 1024 + (hb + bj) * 128 + ii;
          *(u32x2*)(rp) = pack4(o1);
          *(u32x2*)(rp + 64) = pack4(o2);
        }
      }
    }
  } else if (kind == 8) {
    const bool isv = u.pn >= 4;
    float* of = p.out + (isv ? O_MV : O_MK);
    bf16_t* ob = (bf16_t*)(ws + (isv ? WS_MVB : WS_MKB));
    const int cb = (u.pn & 3) * 256;
#pragma unroll
    for (int ai = 0; ai < 2; ++ai)
#pragma unroll
      for (int m = 0; m < 4; ++m) {
        const size_t ro = (size_t)(row0 + ai * 128 + m * 16) * 1024 + cb + ct0;
#pragma unroll
        for (int bj = 0; bj < 2; ++bj)
#pragma unroll
          for (int n = 0; n < 2; ++n) {
            const f32x4 v = acc[ai][bj][m][n];
            *(f32x4*)(of + ro + bj * 128 + n * 16) = v;
            *(u32x2*)(ob + ro + bj * 128 + n * 16) = pack4(v);
          }
      }
  } else if (kind >= 9 && kind <= 11) {
    const int seg = kind - 9;
    const bf16_t* gates = (const bf16_t*)(ws + WS_GATES);
    float* mf = (float*)(ws + WS_MERGED);
    bf16_t* mb = (bf16_t*)(ws + WS_MERGEDB);
    const int cb = u.pn * 256 + ct0;
#pragma unroll
    for (int ai = 0; ai < 2; ++ai)
#pragma unroll
      for (int mp = 0; mp < 2; ++mp) {
        u32x2 gr[2][2][2]; f32x4 mv[2][2][2];
#pragma unroll
        for (int mm = 0; mm < 2; ++mm)
#pragma unroll
          for (int bj = 0; bj < 2; ++bj)
#pragma unroll
            for (int n = 0; n < 2; ++n) {
              const size_t row = (size_t)(row0 + ai * 128 + (mp * 2 + mm) * 16);
              const int col = cb + bj * 128 + n * 16;
              gr[mm][bj][n] = *(const u32x2*)(gates + row * 6144 + seg * 2048 + col);
              if (seg > 0) mv[mm][bj][n] = *(const f32x4*)(mf + row * 2048 + col);
            }
#pragma unroll
        for (int mm = 0; mm < 2; ++mm)
#pragma unroll
          for (int bj = 0; bj < 2; ++bj)
#pragma unroll
            for (int n = 0; n < 2; ++n) {
              const size_t row = (size_t)(row0 + ai * 128 + (mp * 2 + mm) * 16);
              const int col = cb + bj * 128 + n * 16;
              f32x4 v = acc[ai][bj][mp * 2 + mm][n] * unpack4(gr[mm][bj][n]);
              if (seg > 0) v += mv[mm][bj][n];
              if (seg < 2) *(f32x4*)(mf + row * 2048 + col) = v;
              else *(u32x2*)(mb + row * 2048 + col) = pack4(v);
            }
      }
  } else if (kind == 12) {
    float* xo = (float*)(ws + WS_X1);
    const int cb = u.pn * 256 + ct0;
#pragma unroll
    for (int ai = 0; ai < 2; ++ai)
#pragma unroll
      for (int mp = 0; mp < 2; ++mp) {
        f32x4 xv[2][2][2];
#pragma unroll
        for (int mm = 0; mm < 2; ++mm) {
          const int row = row0 + ai * 128 + (mp * 2 + mm) * 16;
          const float* xr = row < TOKP ? p.in[0] + (size_t)row * 2048 : p.in[1] + (size_t)(row - TOKP) * 2048;
#pragma unroll
          for (int bj = 0; bj < 2; ++bj)
#pragma unroll
            for (int n = 0; n < 2; ++n) xv[mm][bj][n] = *(const f32x4*)(xr + cb + bj * 128 + n * 16);
        }
#pragma unroll
        for (int mm = 0; mm < 2; ++mm) {
          const int row = row0 + ai * 128 + (mp * 2 + mm) * 16;
#pragma unroll
          for (int bj = 0; bj < 2; ++bj)
#pragma unroll
            for (int n = 0; n < 2; ++n) *(f32x4*)(xo + (size_t)row * 2048 + cb + bj * 128 + n * 16) = xv[mm][bj][n] * ALPHA + acc[ai][bj][mp * 2 + mm][n];
        }
      }
  } else if (kind == 13) {
    bf16_t* act = (bf16_t*)(ws + WS_ACT);
    const int fb = u.pn * 128 + 16 * wc + 4 * fq;
#pragma unroll
    for (int ai = 0; ai < 2; ++ai)
#pragma unroll
      for (int m = 0; m < 4; ++m) {
        const size_t row = (size_t)(row0 + ai * 128 + m * 16);
#pragma unroll
        for (int bj = 0; bj < 2; ++bj) {
          const f32x4 g = acc[ai][bj][m][0], uu = acc[ai][bj][m][1];
          f32x4 v; v[0] = siluf_(g[0]) * uu[0]; v[1] = siluf_(g[1]) * uu[1]; v[2] = siluf_(g[2]) * uu[2]; v[3] = siluf_(g[3]) * uu[3];
          *(u32x2*)(act + row * DFF + fb + bj * 64) = pack4(v);
        }
      }
  } else if (kind >= 17) {
    const int seg = kind - 17;
    const bf16_t* gates = (const bf16_t*)(ws + WS_GATES);
    float* pt = (float*)(ws + WS_PART) + (size_t)u.pm * 65536;
    const int trow = (u.pn >> 3) * 256, tcol = (u.pn & 7) * 256;
#pragma unroll
    for (int ai = 0; ai < 2; ++ai)
#pragma unroll
      for (int mp = 0; mp < 2; ++mp) {
        u32x2 gr[2][2][2];
#pragma unroll
        for (int mm = 0; mm < 2; ++mm)
#pragma unroll
          for (int bj = 0; bj < 2; ++bj)
#pragma unroll
            for (int n = 0; n < 2; ++n) {
              const size_t row = (size_t)(trow + wr * 64 + fr + ai * 128 + (mp * 2 + mm) * 16);
              gr[mm][bj][n] = *(const u32x2*)(gates + row * 6144 + seg * 2048 + tcol + ct0 + bj * 128 + n * 16);
            }
#pragma unroll
        for (int mm = 0; mm < 2; ++mm)
#pragma unroll
          for (int bj = 0; bj < 2; ++bj)
#pragma unroll
            for (int n = 0; n < 2; ++n) {
              const int rl = wr * 64 + fr + ai * 128 + (mp * 2 + mm) * 16;
              *(f32x4*)(pt + rl * 256 + ct0 + bj * 128 + n * 16) = acc[ai][bj][mp * 2 + mm][n] * unpack4(gr[mm][bj][n]);
            }
      }
  } else if (kind == 16) {
    float* pt = (float*)(ws + WS_PART) + (size_t)u.pm * 65536;
#pragma unroll
    for (int ai = 0; ai < 2; ++ai)
#pragma unroll
      for (int m = 0; m < 4; ++m) {
        float* rp = pt + (wr * 64 + fr + ai * 128 + m * 16) * 256 + ct0;
#pragma unroll
        for (int bj = 0; bj < 2; ++bj)
#pragma unroll
          for (int n = 0; n < 2; ++n) *(f32x4*)(rp + bj * 128 + n * 16) = acc[ai][bj][m][n];
      }
  } else {
    const float* x1 = (const float*)(ws + WS_X1);
    float* yo = (float*)(ws + WS_YPRE);
    const int cb = u.pn * 256 + ct0;
#pragma unroll
    for (int ai = 0; ai < 2; ++ai)
#pragma unroll
      for (int mp = 0; mp < 2; ++mp) {
        f32x4 xv[2][2][2];
#pragma unroll
        for (int mm = 0; mm < 2; ++mm) {
          const size_t row = (size_t)(row0 + ai * 128 + (mp * 2 + mm) * 16);
#pragma unroll
          for (int bj = 0; bj < 2; ++bj)
#pragma unroll
            for (int n = 0; n < 2; ++n) xv[mm][bj][n] = *(const f32x4*)(x1 + row * 2048 + cb + bj * 128 + n * 16);
        }
#pragma unroll
        for (int mm = 0; mm < 2; ++mm) {
          const size_t row = (size_t)(row0 + ai * 128 + (mp * 2 + mm) * 16);
#pragma unroll
          for (int bj = 0; bj < 2; ++bj)
#pragma unroll
            for (int n = 0; n < 2; ++n) *(f32x4*)(yo + row * 2048 + cb + bj * 128 + n * 16) = xv[mm][bj][n] * ALPHA + acc[ai][bj][mp * 2 + mm][n];
        }
      }
  }
}

__device__ __forceinline__ void gemm_phase(const Params& p, LAS unsigned char* lds, int gph, unsigned ldB  ) {
  int tid = threadIdx.x; asm volatile("" : "+v"(tid));
  const int wid = __builtin_amdgcn_readfirstlane(tid >> 6), lane = tid & 63, wr = wid >> 2, wc = wid & 3, fr = lane & 15, fq = lane >> 4;
  unsigned voff[2];
#pragma unroll
  for (int i = 0; i < 2; ++i) { int R, C; stage_rc(tid * 16 + i * 8192, R, C); voff[i] = (unsigned)R * ldB + (unsigned)C * 2u; }
  const size_t kstep = (size_t)(BK * 2);
  const size_t hstep = (size_t)HALF * ldB;
  const unsigned ldsw = (unsigned)wid * 1024u;
  const int aoff = lds_byte(wr * 64 + fr, fq * 8), boff = lds_byte(wc * 32 + fr, fq * 8);
#define PG8_SA(b, h) (((b) * 2 + (h)) * HTB)
#define PG8_SB(b, h) ((4 + (b) * 2 + (h)) * HTB)
#define PG8_STAGE(bufoff, gbase) do { _Pragma("unroll") for (int _i = 0; _i < 2; ++_i) \
        __builtin_amdgcn_global_load_lds((const unsigned*)((const char*)(gbase) + voff[_i]), (LAS unsigned*)(lds + (bufoff) + ldsw + _i * 8192), 16, 0, 0); } while (0)
#define PG8_LDA(dst, b, h) do { _Pragma("unroll") for (int m = 0; m < 4; ++m) _Pragma("unroll") for (int k = 0; k < 2; ++k) dst[m][k] = *(const LAS bf16x8*)(lds + PG8_SA(b, h) + aoff + m * 2048 + k * 1024); } while (0)
#define PG8_LDB(dst, b, h) do { _Pragma("unroll") for (int n = 0; n < 2; ++n) _Pragma("unroll") for (int k = 0; k < 2; ++k) dst[n][k] = *(const LAS bf16x8*)(lds + PG8_SB(b, h) + boff + n * 2048 + k * 1024); } while (0)
#define PG8_MMA(ai, bj, At, Bt) do { __builtin_amdgcn_s_setprio(1); _Pragma("unroll") for (int m = 0; m < 4; ++m) _Pragma("unroll") for (int n = 0; n < 2; ++n) _Pragma("unroll") for (int k = 0; k < 2; ++k) \
        acc[ai][bj][m][n] = __builtin_amdgcn_mfma_f32_16x16x32_bf16(Bt[n][k], At[m][k], acc[ai][bj][m][n], 0, 0, 0); __builtin_amdgcn_s_setprio(0); } while (0)
#define PG8_WAIT_V(n) asm volatile("s_waitcnt vmcnt(" #n ")" ::: "memory")
#define PG8_WAIT_L(n) asm volatile("s_waitcnt lgkmcnt(" #n ")" ::: "memory")
#define PG8_BAR __builtin_amdgcn_s_barrier()
#define PG8_SCHED __builtin_amdgcn_sched_barrier(0)
  Unit cur, nxt; int ui = 0;
  if (!next_unit(p, gph, 0, cur)) return;
  f32x4 acc[2][2][4][2];
#pragma unroll
  for (int a = 0; a < 2; ++a)
#pragma unroll
    for (int b = 0; b < 2; ++b)
#pragma unroll
      for (int m = 0; m < 4; ++m)
#pragma unroll
        for (int n = 0; n < 2; ++n) acc[a][b][m][n] = (f32x4){0.f, 0.f, 0.f, 0.f};
  bf16x8 At[4][2], B0[2][2], B1[2][2];
  const char* cA = cur.A; const char* cB = cur.B;
  PG8_STAGE(PG8_SB(0, 0), cB); PG8_STAGE(PG8_SA(0, 0), cA); PG8_STAGE(PG8_SB(0, 1), cB + hstep); PG8_STAGE(PG8_SA(0, 1), cA + hstep);
  if (wr == 1) PG8_BAR;
  PG8_WAIT_V(4); PG8_BAR;
  PG8_STAGE(PG8_SB(1, 0), cB + kstep); PG8_STAGE(PG8_SA(1, 0), cA + kstep); PG8_STAGE(PG8_SB(1, 1), cB + hstep + kstep);
  PG8_WAIT_V(6); PG8_BAR;
  for (;;) {
    const bool has_next = next_unit(p, gph, ui + 1, nxt);
    const char* nA = has_next ? nxt.A : cA; const char* nB = has_next ? nxt.B : cB;
    const int nt = cur.nt;
    for (int t = 0; t < nt; t += 2) {
      const bool last = (t == nt - 2);
      const char* a1 = cA + (size_t)(t + 1) * kstep;
      const char* a2 = last ? nA : cA + (size_t)(t + 2) * kstep; const char* b2 = last ? nB : cB + (size_t)(t + 2) * kstep;
      const char* a3 = a2 + kstep; const char* b3 = b2 + kstep;
      PG8_LDB(B0, 0, 0); PG8_SCHED; PG8_LDA(At, 0, 0); PG8_STAGE(PG8_SA(1, 1), a1 + hstep);
      PG8_WAIT_L(8); PG8_BAR; PG8_WAIT_L(0); PG8_MMA(0, 0, At, B0); PG8_BAR; PG8_SCHED;
      PG8_LDB(B1, 0, 1); PG8_STAGE(PG8_SB(0, 0), b2);
      PG8_BAR; PG8_WAIT_L(0); PG8_MMA(0, 1, At, B1); PG8_BAR;
      PG8_LDA(At, 0, 1); PG8_STAGE(PG8_SA(0, 0), a2);
      PG8_BAR; PG8_WAIT_L(0); PG8_MMA(1, 0, At, B0); PG8_BAR; PG8_SCHED;
      PG8_STAGE(PG8_SB(0, 1), b2 + hstep);
      PG8_WAIT_V(6); PG8_BAR; PG8_MMA(1, 1, At, B1); PG8_BAR;
      PG8_LDB(B0, 1, 0); PG8_SCHED; PG8_LDA(At, 1, 0); PG8_STAGE(PG8_SA(0, 1), a2 + hstep);
      PG8_WAIT_L(8); PG8_BAR; PG8_WAIT_L(0); PG8_MMA(0, 0, At, B0); PG8_BAR; PG8_SCHED;
      PG8_LDB(B1, 1, 1); PG8_STAGE(PG8_SB(1, 0), b3);
      PG8_BAR; PG8_WAIT_L(0); PG8_MMA(0, 1, At, B1); PG8_BAR;
      PG8_LDA(At, 1, 1); PG8_STAGE(PG8_SA(1, 0), a3);
      PG8_BAR; PG8_WAIT_L(0); PG8_MMA(1, 0, At, B0); PG8_BAR; PG8_SCHED;
      PG8_STAGE(PG8_SB(1, 1), b3 + hstep);
      PG8_WAIT_V(6); PG8_BAR; PG8_MMA(1, 1, At, B1); PG8_BAR;
    }
    epilogue(p, cur, acc, wr, wc, fr, fq);
    if (!has_next) break;
#pragma unroll
    for (int a = 0; a < 2; ++a)
#pragma unroll
      for (int b = 0; b < 2; ++b)
#pragma unroll
        for (int m = 0; m < 4; ++m)
#pragma unroll
          for (int n = 0; n < 2; ++n) acc[a][b][m][n] = (f32x4){0.f, 0.f, 0.f, 0.f};
    cur = nxt; cA = nA; cB = nB; ++ui;
  }
  PG8_WAIT_V(0);
  if (wr == 0) PG8_BAR;
  PG8_BAR;
#undef PG8_SA
#undef PG8_SB
#undef PG8_STAGE
#undef PG8_LDA
#undef PG8_LDB
#undef PG8_MMA
#undef PG8_WAIT_V
#undef PG8_WAIT_L
#undef PG8_BAR
#undef PG8_SCHED
}

template <int NT> __device__ __forceinline__ void conv_tilesN(const Params& p, LAS unsigned char* lds, int tid, int t0, int stride, int t_end) {
  unsigned char* ws = p.ws;
  LAS float* tile = (LAS float*)lds;
  const int tx = tid & 63, ty = tid >> 6;
  {
    float v[NT][8];
#pragma unroll
    for (int q = 0; q < NT; ++q) {
      const int t = t0 + q * stride;
      if (t < t_end) {
        int mat, loc, ktn;
        if (t < 7680) { mat = 0; loc = t; ktn = 32; }
        else if (t < 9728) { mat = 1; loc = t - 7680; ktn = 64; }
        else if (t < 10752) { mat = 2; loc = t - 9728; ktn = 32; }
        else if (t < 16384) { mat = 3; loc = t - 10752; ktn = 32; }
        else if (t < 19200) { mat = 4; loc = t - 16384; ktn = 88; }
        else { mat = 5; loc = t - 19200; ktn = 32; }
        const int n0 = (loc / ktn) * 64, k0 = (loc % ktn) * 64;
        const int n = n0 + tx;
        const float* ptr; int ld, col, kk0 = k0;
        if (mat == 0) {
          ptr = p.in[6]; ld = INW; col = n;
          if (n >= OFF_RQ && n < OFF_RV) { const int s = n & 127; col = (n & ~127) + ((s >> 4) & 1) * 64 + (s >> 5) * 16 + (s & 15); }
        } else if (mat == 1) {
          ld = 2048; col = n;
          if (k0 < 1024) { ptr = p.in[11]; } else if (k0 < 3072) { ptr = p.in[13]; kk0 = k0 - 1024; } else { ptr = p.in[16]; kk0 = k0 - 3072; }
        } else if (mat == 2) { ptr = p.in[17]; ld = 2048; col = n; }
        else if (mat == 3) {
          const int T = n >> 8, s = n & 255;
          const int f = 128 * T + 64 * (s >> 7) + 16 * ((s >> 5) & 3) + (s & 15);
          ptr = ((s >> 4) & 1) ? p.in[21] : p.in[20]; ld = DFF; col = f;
        } else if (mat == 4) { ptr = p.in[22]; ld = 2048; col = n; }
        else { if (n < 1024) { ptr = p.in[14]; col = n; } else { ptr = p.in[15]; col = n - 1024; } ld = 1024; }
        const float* s0 = ptr + (size_t)(kk0 + ty * 8) * ld + col;
#pragma unroll
        for (int r = 0; r < 8; ++r) v[q][r] = __builtin_nontemporal_load(s0 + (size_t)r * ld);
      }
    }
#pragma unroll
    for (int q = 0; q < NT; ++q) {
      const int t = t0 + q * stride;
      if (t < t_end) {
        int loc, ktn, ldd; size_t dsto;
        if (t < 7680) { loc = t; ktn = 32; ldd = 2048; dsto = WS_WIN; }
        else if (t < 9728) { loc = t - 7680; ktn = 64; ldd = 4096; dsto = WS_WCAT; }
        else if (t < 10752) { loc = t - 9728; ktn = 32; ldd = 2048; dsto = WS_WOUT; }
        else if (t < 16384) { loc = t - 10752; ktn = 32; ldd = 2048; dsto = WS_WGU; }
        else if (t < 19200) { loc = t - 16384; ktn = 88; ldd = 5632; dsto = WS_WDN; }
        else { loc = t - 19200; ktn = 32; ldd = 2048; dsto = WS_WMKV; }
        const int n0 = (loc / ktn) * 64, k0 = (loc % ktn) * 64;
        __syncthreads();
#pragma unroll
        for (int r = 0; r < 8; ++r) tile[(ty * 8 + r) * 65 + tx] = v[q][r];
        __syncthreads();
        const int nn = tid >> 3, kc = (tid & 7) * 8;
        float w[8];
#pragma unroll
        for (int e = 0; e < 8; ++e) w[e] = tile[(kc + e) * 65 + nn];
        u32x4 o; o[0] = cvt_pk(w[0], w[1]); o[1] = cvt_pk(w[2], w[3]); o[2] = cvt_pk(w[4], w[5]); o[3] = cvt_pk(w[6], w[7]);
        __builtin_nontemporal_store(o, (u32x4*)((bf16_t*)(ws + dsto) + (size_t)(n0 + nn) * ldd + k0 + kc));
      }
    }
  }
}

__device__ __forceinline__ void phase_prep(const Params& p, LAS unsigned char* lds) {
  int tid = threadIdx.x; asm volatile("" : "+v"(tid));
  unsigned char* ws = p.ws;
  if (blockIdx.x == 0 && tid < 16) { ((unsigned*)(ws + WS_CTL))[tid] = 0u; }
  {
    float* rope = (float*)(ws + WS_ROPE);
    for (int idx = blockIdx.x * 512 + tid; idx < 2056 * 64; idx += gridDim.x * 512) {
      const int pidx = idx >> 6, i = idx & 63;
      const double pos = pidx < 2048 ? (double)pidx : (double)(16384 + (pidx - 2048));
      double inv = 1.0; for (int k = 0; k < i; ++k) inv *= 0.8659643233600653;
      double rev = pos * inv * 0.15915494309189535;
      rev -= floor(rev);
      const float fr = (float)rev;
      rope[(size_t)idx * 2] = __builtin_amdgcn_cosf(fr);
      rope[(size_t)idx * 2 + 1] = __builtin_amdgcn_sinf(fr);
    }
  }
  {
    const int NCH_X = NTOK * DM / 8, NCH_M = 1024 * 2048 / 8, NCH = NCH_X + NCH_M;
    for (int ch0 = (blockIdx.x * 512 + tid); ch0 < NCH; ch0 += gridDim.x * 512 * 4) {
      f32x4 a[4], b[4];
#pragma unroll
      for (int q = 0; q < 4; ++q) {
        const int ch = ch0 + q * (int)gridDim.x * 512;
        if (ch < NCH) {
          const float* src = ch < TOKP * DM / 8 ? p.in[0] + (size_t)ch * 8 : ch < NCH_X ? p.in[1] + (size_t)(ch - TOKP * DM / 8) * 8 : p.in[2] + (size_t)(ch - NCH_X) * 8;
          a[q] = __builtin_nontemporal_load((const f32x4*)src); b[q] = __builtin_nontemporal_load((const f32x4*)(src + 4));
        }
      }
#pragma unroll
      for (int q = 0; q < 4; ++q) {
        const int ch = ch0 + q * (int)gridDim.x * 512;
        if (ch < NCH) {
          bf16_t* dst = ch < NCH_X ? (bf16_t*)(ws + WS_XB) + (size_t)ch * 8 : (bf16_t*)(ws + WS_MEMB) + (size_t)(ch - NCH_X) * 8;
          u32x4 o; o[0] = cvt_pk(a[q][0], a[q][1]); o[1] = cvt_pk(a[q][2], a[q][3]); o[2] = cvt_pk(b[q][0], b[q][1]); o[3] = cvt_pk(b[q][2], b[q][3]);
          *(u32x4*)dst = o;
        }
      }
    }
  }
  for (int tb = blockIdx.x; tb < 7680; tb += 8 * gridDim.x) conv_tilesN<8>(p, lds, tid, tb, (int)gridDim.x, 7680);
  for (int tb = 19200 + blockIdx.x; tb < 20224; tb += 4 * gridDim.x) conv_tilesN<4>(p, lds, tid, tb, (int)gridDim.x, 20224);
  __syncthreads();
}

__device__ __forceinline__ void conv_queue(const Params& p, LAS unsigned char* lds, unsigned* ctr, int t_begin, int t_end) {
  int tid = threadIdx.x; asm volatile("" : "+v"(tid));
  LAS unsigned* slot = (LAS unsigned*)(lds + LDS_CTL);
  unsigned nxt = 0u;
  if (tid == 0) nxt = atomicAdd(ctr, 4u);
  for (;;) {
    __syncthreads();
    if (tid == 0) *slot = nxt;
    __syncthreads();
    const int base = t_begin + (int)__builtin_amdgcn_readfirstlane(*slot);
    if (base >= t_end) break;
    if (tid == 0) nxt = atomicAdd(ctr, 4u);
    conv_tilesN<4>(p, lds, tid, base, 1, t_end);
  }
}

__device__ __forceinline__ float ret_lg(int h) { return log1pf(-exp2f(-5.0f - (float)h)); }

__device__ __forceinline__ void mix_ret_prompt(const Params& p, LAS unsigned char* lds, int u) {
  int tid = threadIdx.x; asm volatile("" : "+v"(tid)); const int w = tid >> 6, lane = tid & 63, fr = lane & 15, fq = lane >> 4;
  const int b = u >> 5, h = (u >> 2) & 7, es = u & 3;
  unsigned char* ws = p.ws;
  const bf16_t* RQ = (const bf16_t*)(ws + WS_RQ); const bf16_t* RK = (const bf16_t*)(ws + WS_RK); const bf16_t* RV = (const bf16_t*)(ws + WS_RV);
  bf16_t* RO = (bf16_t*)(ws + WS_RO);
  LAS unsigned char* Qi = lds;
  LAS unsigned char* Ki = lds + 34816;
  LAS unsigned char* Vi = lds + 69632;
  LAS unsigned char* Si = lds + 88064;
  const float lg = ret_lg(h);
  const float cd = __expf(128.0f * lg);
  const int irow = 16 * w + fr;
  const float sa = __expf((float)(irow - 127) * lg), sb = __expf((float)(irow + 1) * lg);
  f32x4 accS[4];
#pragma unroll
  for (int n = 0; n < 4; ++n) accS[n] = (f32x4){0.f, 0.f, 0.f, 0.f};
  u32x4 nq[4], nk[4], nv[2];
#pragma unroll
  for (int it = 0; it < 4; ++it) {
    const int ch = tid + it * 512, row = ch >> 4, cc = ch & 15;
    nq[it] = *(const u32x4*)(RQ + (size_t)(b * 2048 + row) * 1024 + h * 128 + cc * 8);
    nk[it] = *(const u32x4*)(RK + (size_t)(b * 2048 + row) * 1024 + h * 128 + cc * 8);
  }
#pragma unroll
  for (int it = 0; it < 2; ++it) {
    const int ch = tid + it * 512, row = ch >> 3, cc = ch & 7;
    nv[it] = *(const u32x4*)(RV + (size_t)(b * 2048 + row) * 2048 + h * 256 + es * 64 + cc * 8);
  }
  for (int c = 0; c < 16; ++c) {
    const int t0 = b * 2048 + c * 128;
    __syncthreads();
#pragma unroll
    for (int it = 0; it < 4; ++it) {
      const int ch = tid + it * 512, row = ch >> 4, cc = ch & 15;
      *(LAS u32x4*)(Qi + row * 272 + cc * 16) = nq[it];
      *(LAS u32x4*)(Ki + row * 272 + cc * 16) = nk[it];
    }
#pragma unroll
    for (int it = 0; it < 2; ++it) {
      const int ch = tid + it * 512, row = ch >> 3, cc = ch & 7;
      const u32x4 vv = nv[it];
      const float sc = __expf((float)(127 - row) * lg);
      u32x4 o;
#pragma unroll
      for (int e = 0; e < 4; ++e) o[e] = cvt_pk(bflo(vv[e]) * sc, bfhi(vv[e]) * sc);
      *(LAS u32x4*)(Vi + row * 144 + cc * 16) = o;
    }
#pragma unroll
    for (int n = 0; n < 4; ++n) *(LAS u32x2*)(Si + irow * 144 + (16 * n + 4 * fq) * 2) = pack4(accS[n]);
    if (c + 1 < 16) {
      const int t1 = t0 + 128;
#pragma unroll
      for (int it = 0; it < 4; ++it) {
        const int ch = tid + it * 512, row = ch >> 4, cc = ch & 15;
        nq[it] = *(const u32x4*)(RQ + (size_t)(t1 + row) * 1024 + h * 128 + cc * 8);
        nk[it] = *(const u32x4*)(RK + (size_t)(t1 + row) * 1024 + h * 128 + cc * 8);
      }
#pragma unroll
      for (int it = 0; it < 2; ++it) {
        const int ch = tid + it * 512, row = ch >> 3, cc = ch & 7;
        nv[it] = *(const u32x4*)(RV + (size_t)(t1 + row) * 2048 + h * 256 + es * 64 + cc * 8);
      }
    }
    __syncthreads();
    bf16x8 Qf[4];
#pragma unroll
    for (int ks = 0; ks < 4; ++ks) Qf[ks] = ldfrag(Qi, irow, 32 * ks + 8 * fq, 272);
    f32x4 sc8[8];
#pragma unroll
    for (int nt = 0; nt < 8; ++nt) {
      sc8[nt] = (f32x4){0.f, 0.f, 0.f, 0.f};
#pragma unroll
      for (int ks = 0; ks < 4; ++ks) sc8[nt] = MFMA16(ldfrag(Ki, 16 * nt + fr, 32 * ks + 8 * fq, 272), Qf[ks], sc8[nt]);
#pragma unroll
      for (int j = 0; j < 4; ++j) if (16 * nt + 4 * fq + j > irow) sc8[nt][j] = 0.f;
    }
    bf16x8 Pf[4];
#pragma unroll
    for (int k2 = 0; k2 < 4; ++k2) {
      const u32x2 lo = pack4(sc8[2 * k2]), hi = pack4(sc8[2 * k2 + 1]);
      const u32x4 t = (u32x4){lo[0], lo[1], hi[0], hi[1]};
      Pf[k2] = __builtin_bit_cast(bf16x8, t);
    }
    bf16x8 Vf[4][4];
#pragma unroll
    for (int n = 0; n < 4; ++n)
#pragma unroll
      for (int k2 = 0; k2 < 4; ++k2) Vf[n][k2] = ldfrag_tr(Vi, 32 * k2 + 4 * fq, 32 * k2 + 16 + 4 * fq, 16 * n, 144, lane);
#pragma unroll
    for (int n = 0; n < 4; ++n) {
      f32x4 aA = (f32x4){0.f, 0.f, 0.f, 0.f}, aB = (f32x4){0.f, 0.f, 0.f, 0.f};
#pragma unroll
      for (int k2 = 0; k2 < 4; ++k2) aA = MFMA16(Vf[n][k2], Pf[k2], aA);
#pragma unroll
      for (int ks = 0; ks < 4; ++ks) aB = MFMA16(ldfrag_tr(Si, 32 * ks + 8 * fq, 32 * ks + 8 * fq + 4, 16 * n, 144, lane), Qf[ks], aB);
      const f32x4 o = aA * sa + aB * sb;
      *(u32x2*)(RO + (size_t)(t0 + irow) * 2048 + h * 256 + es * 64 + 16 * n + 4 * fq) = pack4(o);
    }
    bf16x8 Kt[4];
#pragma unroll
    for (int k2 = 0; k2 < 4; ++k2) Kt[k2] = ldfrag_tr(Ki, 32 * k2 + 4 * fq, 32 * k2 + 16 + 4 * fq, 16 * w, 272, lane);
#pragma unroll
    for (int n = 0; n < 4; ++n) {
      accS[n] = accS[n] * cd;
#pragma unroll
      for (int k2 = 0; k2 < 4; ++k2) accS[n] = MFMA16(Vf[n][k2], Kt[k2], accS[n]);
    }
  }
  float* so = p.out + O_SRP + ((size_t)(b * 8 + h) * 128 + irow) * 256 + es * 64;
#pragma unroll
  for (int n = 0; n < 4; ++n) *(f32x4*)(so + 16 * n + 4 * fq) = accS[n];
}

__device__ __forceinline__ void mix_ret_sample(const Params& p, LAS unsigned char* lds, int u) {
  int tid = threadIdx.x; asm volatile("" : "+v"(tid)); const int w = tid >> 6, lane = tid & 63;
  const int b = u >> 3, h = u & 7;
  unsigned char* ws = p.ws;
  const bf16_t* RQ = (const bf16_t*)(ws + WS_RQ); const bf16_t* RK = (const bf16_t*)(ws + WS_RK); const bf16_t* RV = (const bf16_t*)(ws + WS_RV);
  const bf16_t* RG = (const bf16_t*)(ws + WS_RG);
  bf16_t* ACAT = (bf16_t*)(ws + WS_ACAT);
  LAS float* qT = (LAS float*)lds;
  LAS float* kT = (LAS float*)(lds + 4096);
  LAS float* scs = (LAS float*)(lds + 8192);
  LAS float* red = (LAS float*)(lds + 8704);
  const float lg = ret_lg(h);
  const int r0 = TOKP + 8 * b;
  f32x4 s0v[16];
  {
    const float* S0p = p.in[3] + ((size_t)(b * 8 + h) * 128 + 16 * w) * 256 + 4 * lane;
#pragma unroll
    for (int dd = 0; dd < 16; ++dd) s0v[dd] = __builtin_nontemporal_load((const f32x4*)(S0p + dd * 256));
  }
  __syncthreads();
  for (int idx = tid; idx < 1024; idx += 512) {
    const int i = idx >> 7, d = idx & 127;
    qT[d * 8 + i] = bflo((unsigned)RQ[(size_t)(r0 + i) * 1024 + h * 128 + d]);
    kT[d * 8 + i] = bflo((unsigned)RK[(size_t)(r0 + i) * 1024 + h * 128 + d]) * __expf((float)(7 - i) * lg);
  }
  const int e4 = 4 * lane;
  f32x4 vv[8];
#pragma unroll
  for (int j = 0; j < 8; ++j) vv[j] = unpack4(*(const u32x2*)(RV + (size_t)(r0 + j) * 2048 + h * 256 + e4));
  __syncthreads();
  if (tid < 64) {
    const int i = tid >> 3, j = tid & 7;
    float s = 0.f;
    for (int d = 0; d < 128; ++d) s += qT[d * 8 + i] * kT[d * 8 + j];
    scs[tid] = j <= i ? s * __expf((float)(i - 7) * lg) : 0.f;
  }
  const float cd = __expf(8.0f * lg);
  f32x4 acc[8];
#pragma unroll
  for (int i = 0; i < 8; ++i) acc[i] = (f32x4){0.f, 0.f, 0.f, 0.f};
  const float* S0 = p.in[3] + ((size_t)(b * 8 + h) * 128 + 16 * w) * 256 + e4;
  float* S1 = p.out + O_SRS + ((size_t)(b * 8 + h) * 128 + 16 * w) * 256 + e4;
#pragma unroll
  for (int dd = 0; dd < 16; ++dd) {
    const int d = 16 * w + dd;
    const f32x4 s0 = s0v[dd];
    const f32x4 qa = *(const LAS f32x4*)(qT + d * 8), qb = *(const LAS f32x4*)(qT + d * 8 + 4);
    const f32x4 ka = *(const LAS f32x4*)(kT + d * 8), kb = *(const LAS f32x4*)(kT + d * 8 + 4);
    acc[0] += s0 * qa[0]; acc[1] += s0 * qa[1]; acc[2] += s0 * qa[2]; acc[3] += s0 * qa[3];
    acc[4] += s0 * qb[0]; acc[5] += s0 * qb[1]; acc[6] += s0 * qb[2]; acc[7] += s0 * qb[3];
    f32x4 sn = s0 * cd;
    sn += vv[0] * ka[0]; sn += vv[1] * ka[1]; sn += vv[2] * ka[2]; sn += vv[3] * ka[3];
    sn += vv[4] * kb[0]; sn += vv[5] * kb[1]; sn += vv[6] * kb[2]; sn += vv[7] * kb[3];
    __builtin_nontemporal_store(sn, (f32x4*)(S1 + dd * 256));
  }
#pragma unroll
  for (int i = 0; i < 8; ++i) *(LAS f32x4*)(red + (w * 8 + i) * 256 + e4) = acc[i];
  __syncthreads();
  {
    const int i = w;
    f32x4 o = (f32x4){0.f, 0.f, 0.f, 0.f};
#pragma unroll
    for (int ww = 0; ww < 8; ++ww) o += *(const LAS f32x4*)(red + (ww * 8 + i) * 256 + e4);
    o = o * __expf((float)(i + 1) * lg);
#pragma unroll
    for (int j = 0; j < 8; ++j) o += vv[j] * scs[i * 8 + j];
    const float mean = wave_sum(o[0] + o[1] + o[2] + o[3]) * (1.0f / 256.0f);
    const f32x4 dlt = o - mean;
    const float var = wave_sum(dlt[0] * dlt[0] + dlt[1] * dlt[1] + dlt[2] * dlt[2] + dlt[3] * dlt[3]) * (1.0f / 256.0f);
    const float rstd = rsqrtf(var + LN_EPS);
    const f32x4 gn = *(const f32x4*)(p.in[12] + h * 256 + e4);
    const f32x4 sg = unpack4(*(const u32x2*)(RG + (size_t)(r0 + i) * 2048 + h * 256 + e4));
    const f32x4 r = dlt * rstd * gn * sg;
    *(u32x2*)(ACAT + (size_t)(r0 + i) * 4096 + 1024 + h * 256 + e4) = pack4(r);
  }
}

__device__ __forceinline__ void mix_sg_prompt(const Params& p, LAS unsigned char* lds, int u) {
  int tid = threadIdx.x; asm volatile("" : "+v"(tid)); const int w = tid >> 6, lane = tid & 63, fr = lane & 15, fq = lane >> 4;
  const int b = u >> 6, c = (u >> 2) & 15, g = u & 3;
  unsigned char* ws = p.ws;
  const bf16_t* VA = (const bf16_t*)(ws + WS_VA); const bf16_t* U = (const bf16_t*)(ws + WS_U);
  bf16_t* ACAT = (bf16_t*)(ws + WS_ACAT);
  LAS unsigned char* Vs = lds;
  LAS unsigned char* Wsm = lds + 67584;
  const int t0 = b * 2048 + c * 128;
  __syncthreads();
  {
    const int row = tid >> 2, part = tid & 3;
    const bf16_t* src = VA + (size_t)(t0 + row) * 1024 + g * 256;
    u32x4 raw[8];
#pragma unroll
    for (int k = 0; k < 8; ++k) raw[k] = *(const u32x4*)(src + (part + 4 * k) * 8);
    float s = 0.f;
#pragma unroll
    for (int k = 0; k < 8; ++k)
#pragma unroll
      for (int e = 0; e < 4; ++e) s += bflo(raw[k][e]) + bfhi(raw[k][e]);
    s += __shfl_xor(s, 1); s += __shfl_xor(s, 2);
    const float mean = s * (1.0f / 256.0f);
    float q = 0.f;
#pragma unroll
    for (int k = 0; k < 8; ++k)
#pragma unroll
      for (int e = 0; e < 4; ++e) { const float a = bflo(raw[k][e]) - mean, bb = bfhi(raw[k][e]) - mean; q += a * a + bb * bb; }
    q += __shfl_xor(q, 1); q += __shfl_xor(q, 2);
    const float rstd = rsqrtf(q * (1.0f / 256.0f) + LN_EPS);
    const float* lng = p.in[7] + g * 256; const float* lnb = p.in[8] + g * 256;
#pragma unroll
    for (int k = 0; k < 8; ++k) {
      const int col = (part + 4 * k) * 8;
      const f32x4 g0 = *(const f32x4*)(lng + col), g1 = *(const f32x4*)(lng + col + 4);
      const f32x4 b0 = *(const f32x4*)(lnb + col), b1 = *(const f32x4*)(lnb + col + 4);
      u32x4 o;
      o[0] = cvt_pk((bflo(raw[k][0]) - mean) * rstd * g0[0] + b0[0], (bfhi(raw[k][0]) - mean) * rstd * g0[1] + b0[1]);
      o[1] = cvt_pk((bflo(raw[k][1]) - mean) * rstd * g0[2] + b0[2], (bfhi(raw[k][1]) - mean) * rstd * g0[3] + b0[3]);
      o[2] = cvt_pk((bflo(raw[k][2]) - mean) * rstd * g1[0] + b1[0], (bfhi(raw[k][2]) - mean) * rstd * g1[1] + b1[1]);
      o[3] = cvt_pk((bflo(raw[k][3]) - mean) * rstd * g1[2] + b1[2], (bfhi(raw[k][3]) - mean) * rstd * g1[3] + b1[3]);
      *(LAS u32x4*)(Vs + row * 528 + col * 2) = o;
    }
    const float* wsrc = p.in[9] + ((size_t)g * 128 + row) * 128 + part * 32;
#pragma unroll
    for (int k = 0; k < 4; ++k) {
      const f32x4 a = *(const f32x4*)(wsrc + k * 8), bb = *(const f32x4*)(wsrc + k * 8 + 4);
      const int j0 = part * 32 + k * 8;
      float v[8] = {a[0], a[1], a[2], a[3], bb[0], bb[1], bb[2], bb[3]};
#pragma unroll
      for (int e = 0; e < 8; ++e) if (j0 + e > row) v[e] = 0.f;
      u32x4 o; o[0] = cvt_pk(v[0], v[1]); o[1] = cvt_pk(v[2], v[3]); o[2] = cvt_pk(v[4], v[5]); o[3] = cvt_pk(v[6], v[7]);
      *(LAS u32x4*)(Wsm + row * 272 + j0 * 2) = o;
    }
  }
  __syncthreads();
  const int irow = 16 * w + fr;
  f32x4 acc[16];
#pragma unroll
  for (int n = 0; n < 16; ++n) acc[n] = (f32x4){0.f, 0.f, 0.f, 0.f};
#pragma unroll
  for (int ks = 0; ks < 4; ++ks) {
    const bf16x8 Af = ldfrag(Wsm, irow, 32 * ks + 8 * fq, 272);
#pragma unroll
    for (int n = 0; n < 16; ++n) acc[n] = MFMA16(ldfrag_tr(Vs, 32 * ks + 8 * fq, 32 * ks + 8 * fq + 4, 16 * n, 528, lane), Af, acc[n]);
  }
  const float bias = p.in[10][g * 128 + irow];
#pragma unroll
  for (int n = 0; n < 16; ++n) {
    const int d = 16 * n + 4 * fq;
    const f32x4 uu = unpack4(*(const u32x2*)(U + (size_t)(t0 + irow) * 1024 + g * 256 + d));
    const f32x4 o = uu * (acc[n] + bias);
    *(u32x2*)(ACAT + (size_t)(t0 + irow) * 4096 + g * 256 + d) = pack4(o);
  }
}

__device__ __forceinline__ void mix_sg_sample(const Params& p, LAS unsigned char* lds, int b) {
  int tid = threadIdx.x; asm volatile("" : "+v"(tid)); const int w = tid >> 6, lane = tid & 63;
  unsigned char* ws = p.ws;
  const bf16_t* VA = (const bf16_t*)(ws + WS_VA); const bf16_t* U = (const bf16_t*)(ws + WS_U);
  bf16_t* ACAT = (bf16_t*)(ws + WS_ACAT);
  LAS float* vs = (LAS float*)lds;
  const int r0 = TOKP + 8 * b;
  __syncthreads();
#pragma unroll
  for (int g = 0; g < 4; ++g) {
    const int col = g * 256 + 4 * lane;
    const f32x4 x = unpack4(*(const u32x2*)(VA + (size_t)(r0 + w) * 1024 + col));
    const float mean = wave_sum(x[0] + x[1] + x[2] + x[3]) * (1.0f / 256.0f);
    const f32x4 d = x - mean;
    const float var = wave_sum(d[0] * d[0] + d[1] * d[1] + d[2] * d[2] + d[3] * d[3]) * (1.0f / 256.0f);
    const float rstd = rsqrtf(var + LN_EPS);
    const f32x4 gg = *(const f32x4*)(p.in[7] + col), bb = *(const f32x4*)(p.in[8] + col);
    const f32x4 va = d * rstd * gg + bb;
    *(f32x4*)(p.out + O_CV + (size_t)(b * 8 + w) * 1024 + col) = va;
    *(LAS f32x4*)(vs + w * 1024 + col) = va;
  }
  __syncthreads();
#pragma unroll
  for (int g = 0; g < 4; ++g) {
    const int col = g * 256 + 4 * lane;
    const float bias = p.in[10][g * 128 + w];
    f32x4 z = (f32x4){bias, bias, bias, bias};
    for (int j = 0; j <= w; ++j) {
      const float wv = p.in[9][((size_t)g * 128 + w) * 128 + j];
      z += *(const LAS f32x4*)(vs + j * 1024 + col) * wv;
    }
    const f32x4 uu = unpack4(*(const u32x2*)(U + (size_t)(r0 + w) * 1024 + col));
    *(u32x2*)(ACAT + (size_t)(r0 + w) * 4096 + col) = pack4(uu * z);
  }
}

__device__ __forceinline__ void mix_ma_prompt(const Params& p, LAS unsigned char* lds, int u) {
  int tid = threadIdx.x; asm volatile("" : "+v"(tid)); const int w = tid >> 6, lane = tid & 63, fr = lane & 15, fq = lane >> 4;
  const int b = u >> 6, h = (u >> 4) & 3, qt = u & 15;
  unsigned char* ws = p.ws;
  const bf16_t* MQ = (const bf16_t*)(ws + WS_MQ); const bf16_t* MK = (const bf16_t*)(ws + WS_MKB); const bf16_t* MV = (const bf16_t*)(ws + WS_MVB);
  bf16_t* ACAT = (bf16_t*)(ws + WS_ACAT);
  LAS unsigned char* KV = lds;
  const int irow = b * 2048 + qt * 128 + 16 * w + fr;
  __syncthreads();
#pragma unroll
  for (int it = 0; it < 16; ++it) {
    const int ch = tid + it * 512, row = ch >> 5, cc = ch & 31;
    *(LAS u32x4*)(KV + row * 528 + cc * 16) = *(const u32x4*)(MK + (size_t)(b * 256 + row) * 1024 + h * 256 + cc * 8);
  }
  bf16x8 Qf[8];
#pragma unroll
  for (int ks = 0; ks < 8; ++ks) Qf[ks] = *(const bf16x8*)(MQ + (size_t)irow * 1024 + h * 256 + 32 * ks + 8 * fq);
  __syncthreads();
  f32x4 s[16];
#pragma unroll
  for (int n = 0; n < 16; ++n) {
    s[n] = (f32x4){0.f, 0.f, 0.f, 0.f};
#pragma unroll
    for (int ks = 0; ks < 8; ++ks) s[n] = MFMA16(ldfrag(KV, 16 * n + fr, 32 * ks + 8 * fq, 528), Qf[ks], s[n]);
  }
  float mx = -3.0e38f;
#pragma unroll
  for (int n = 0; n < 16; ++n) mx = fmaxf(mx, fmaxf(fmaxf(s[n][0], s[n][1]), fmaxf(s[n][2], s[n][3])));
  mx = fmaxf(mx, __shfl_xor(mx, 16)); mx = fmaxf(mx, __shfl_xor(mx, 32));
  float sum = 0.f;
#pragma unroll
  for (int n = 0; n < 16; ++n)
#pragma unroll
    for (int j = 0; j < 4; ++j) { const float e = __expf(s[n][j] - mx); s[n][j] = e; sum += e; }
  sum += __shfl_xor(sum, 16); sum += __shfl_xor(sum, 32);
  const float inv = 1.0f / sum;
  bf16x8 Pf[8];
#pragma unroll
  for (int k2 = 0; k2 < 8; ++k2) {
    const u32x2 lo = pack4(s[2 * k2]), hi = pack4(s[2 * k2 + 1]);
    const u32x4 t = (u32x4){lo[0], lo[1], hi[0], hi[1]};
    Pf[k2] = __builtin_bit_cast(bf16x8, t);
  }
  __syncthreads();
#pragma unroll
  for (int it = 0; it < 16; ++it) {
    const int ch = tid + it * 512, row = ch >> 5, cc = ch & 31;
    *(LAS u32x4*)(KV + row * 528 + cc * 16) = *(const u32x4*)(MV + (size_t)(b * 256 + row) * 1024 + h * 256 + cc * 8);
  }
  __syncthreads();
#pragma unroll
  for (int n = 0; n < 16; ++n) {
    f32x4 o = (f32x4){0.f, 0.f, 0.f, 0.f};
#pragma unroll
    for (int k2 = 0; k2 < 8; ++k2) o = MFMA16(ldfrag_tr(KV, 32 * k2 + 4 * fq, 32 * k2 + 16 + 4 * fq, 16 * n, 528, lane), Pf[k2], o);
    *(u32x2*)(ACAT + (size_t)irow * 4096 + 3072 + h * 256 + 16 * n + 4 * fq) = pack4(o * inv);
  }
}

__device__ __forceinline__ void mix_ma_sample(const Params& p, LAS unsigned char* lds, int u) {
  int tid = threadIdx.x; asm volatile("" : "+v"(tid)); const int w = tid >> 6, lane = tid & 63, fr = lane & 15, fq = lane >> 4;
  const int b = u >> 2, h = u & 3;
  unsigned char* ws = p.ws;
  const bf16_t* MQ = (const bf16_t*)(ws + WS_MQ);
  bf16_t* ACAT = (bf16_t*)(ws + WS_ACAT);
  LAS unsigned char* KV = lds;
  LAS float* Sc = (LAS float*)(lds + 135168);
  LAS unsigned char* Pb = lds + 135168 + 8192;
  const int r0 = TOKP + 8 * b;
  const float* Kc = p.in[4] + ((size_t)b * 256 * 4 + h) * 256;
  const float* Vc = p.in[5] + ((size_t)b * 256 * 4 + h) * 256;
  __syncthreads();
  bf16x8 Qf[8];
#pragma unroll
  for (int ks = 0; ks < 8; ++ks) Qf[ks] = *(const bf16x8*)(MQ + (size_t)(r0 + (fr & 7)) * 1024 + h * 256 + 32 * ks + 8 * fq);
#pragma unroll 1
  for (int it0 = 0; it0 < 32; it0 += 16) {
    f32x4 t[16];
#pragma unroll
    for (int k = 0; k < 16; ++k) { const int ch = tid + (it0 + k) * 512, row = ch >> 6, cc = ch & 63; t[k] = __builtin_nontemporal_load((const f32x4*)(Kc + (size_t)row * 1024 + cc * 4)); }
#pragma unroll
    for (int k = 0; k < 16; ++k) { const int ch = tid + (it0 + k) * 512, row = ch >> 6, cc = ch & 63; *(LAS u32x2*)(KV + row * 528 + cc * 8) = pack4(t[k]); }
  }
  f32x4 tv[16];
#pragma unroll
  for (int k = 0; k < 16; ++k) { const int ch = tid + k * 512, row = ch >> 6, cc = ch & 63; tv[k] = __builtin_nontemporal_load((const f32x4*)(Vc + (size_t)row * 1024 + cc * 4)); }
  __syncthreads();
#pragma unroll
  for (int t2 = 0; t2 < 2; ++t2) {
    const int n = 2 * w + t2;
    f32x4 s = (f32x4){0.f, 0.f, 0.f, 0.f};
#pragma unroll
    for (int ks = 0; ks < 8; ++ks) s = MFMA16(ldfrag(KV, 16 * n + fr, 32 * ks + 8 * fq, 528), Qf[ks], s);
    if (fr < 8) *(LAS f32x4*)(Sc + fr * 256 + 16 * n + 4 * fq) = s;
  }
  __syncthreads();
#pragma unroll
  for (int k = 0; k < 16; ++k) { const int ch = tid + k * 512, row = ch >> 6, cc = ch & 63; *(LAS u32x2*)(KV + row * 528 + cc * 8) = pack4(tv[k]); }
  {
    f32x4 t[16];
#pragma unroll
    for (int k = 0; k < 16; ++k) { const int ch = tid + (16 + k) * 512, row = ch >> 6, cc = ch & 63; t[k] = __builtin_nontemporal_load((const f32x4*)(Vc + (size_t)row * 1024 + cc * 4)); }
    {
      f32x4 sv = *(const LAS f32x4*)(Sc + w * 256 + 4 * lane);
      const float mx = wave_max(fmaxf(fmaxf(sv[0], sv[1]), fmaxf(sv[2], sv[3])));
      sv[0] = __expf(sv[0] - mx); sv[1] = __expf(sv[1] - mx); sv[2] = __expf(sv[2] - mx); sv[3] = __expf(sv[3] - mx);
      const float inv = 1.0f / wave_sum(sv[0] + sv[1] + sv[2] + sv[3]);
      *(LAS u32x2*)(Pb + w * 528 + lane * 8) = pack4(sv * inv);
    }
#pragma unroll
    for (int k = 0; k < 16; ++k) { const int ch = tid + (16 + k) * 512, row = ch >> 6, cc = ch & 63; *(LAS u32x2*)(KV + row * 528 + cc * 8) = pack4(t[k]); }
  }
  __syncthreads();
#pragma unroll
  for (int t2 = 0; t2 < 2; ++t2) {
    const int n = 2 * w + t2;
    f32x4 o = (f32x4){0.f, 0.f, 0.f, 0.f};
#pragma unroll
    for (int ks = 0; ks < 8; ++ks) o = MFMA16(ldfrag_tr(KV, 32 * ks + 8 * fq, 32 * ks + 8 * fq + 4, 16 * n, 528, lane), ldfrag(Pb, fr, 32 * ks + 8 * fq, 528), o);
    if (fr < 8) *(u32x2*)(ACAT + (size_t)(r0 + fr) * 4096 + 3072 + h * 256 + 16 * n + 4 * fq) = pack4(o);
  }
}

__device__ __forceinline__ void phase_mixers(const Params& p, LAS unsigned char* lds, int rep) {
  unsigned* ctr = (unsigned*)(p.ws + WS_CTL) + rep;
  LAS unsigned* slot = (LAS unsigned*)(lds + LDS_CTL);
  unsigned nxt = 0u;
  if (threadIdx.x == 0) nxt = atomicAdd(ctr, 1u);
  for (;;) {
    __syncthreads();
    if (threadIdx.x == 0) *slot = nxt;
    __syncthreads();
    const int u = (int)__builtin_amdgcn_readfirstlane(*slot);
    if (u >= 2304) break;
    if (threadIdx.x == 0) nxt = atomicAdd(ctr, 1u);
    if (u < 128) mix_ret_prompt(p, lds, u);
    else {
      const int v = u - 128, g = v / 17, s = v % 17;
      if (s < 8) mix_ret_sample(p, lds, g * 8 + s);
      else if (s < 12) mix_ma_sample(p, lds, g * 4 + (s - 8));
      else if (s < 14) mix_ma_prompt(p, lds, g * 2 + (s - 12));
      else if (s < 16) mix_sg_prompt(p, lds, g * 2 + (s - 14));
      else mix_sg_sample(p, lds, g);
    }
  }
}

__device__ __forceinline__ void phase_retpost(const Params& p) {
  int tid = threadIdx.x; asm volatile("" : "+v"(tid));
  const int w = tid >> 6, lane = tid & 63;
  unsigned char* ws = p.ws;
  const bf16_t* RO = (const bf16_t*)(ws + WS_RO); const bf16_t* RG = (const bf16_t*)(ws + WS_RG);
  bf16_t* ACAT = (bf16_t*)(ws + WS_ACAT);
  for (int pr0 = (blockIdx.x * 8 + w) * 8; pr0 < TOKP * 8; pr0 += gridDim.x * 8 * 8) {
    u32x2 xr[8], sr[8];
#pragma unroll
    for (int q = 0; q < 8; ++q) {
      const int pr = pr0 + q, r = pr >> 3, h = pr & 7;
      const size_t o = (size_t)r * 2048 + h * 256 + 4 * lane;
      xr[q] = *(const u32x2*)(RO + o);
      sr[q] = *(const u32x2*)(RG + o);
    }
#pragma unroll
    for (int q = 0; q < 8; ++q) {
      const int pr = pr0 + q, r = pr >> 3, h = pr & 7;
      const f32x4 x = unpack4(xr[q]);
      const float mean = wave_sum(x[0] + x[1] + x[2] + x[3]) * (1.0f / 256.0f);
      const f32x4 d = x - mean;
      const float var = wave_sum(d[0] * d[0] + d[1] * d[1] + d[2] * d[2] + d[3] * d[3]) * (1.0f / 256.0f);
      const float rstd = rsqrtf(var + LN_EPS);
      const f32x4 gn = *(const f32x4*)(p.in[12] + h * 256 + 4 * lane);
      const f32x4 sg = unpack4(sr[q]);
      *(u32x2*)(ACAT + (size_t)r * 4096 + 1024 + h * 256 + 4 * lane) = pack4(d * rstd * gn * sg);
    }
  }
}

__device__ __forceinline__ void ln_load_row(const Params& p, const float* src, int which, int r, int lane, f32x4 (&x)[8]) {
  const float* part = (const float*)(p.ws + WS_PART);
  const float* s = src + (size_t)r * 2048;
  const float* rs = which == 0 ? (r < TOKP ? p.in[0] + (size_t)r * 2048 : p.in[1] + (size_t)(r - TOKP) * 2048) : (const float*)(p.ws + WS_X1) + (size_t)r * 2048;
  const int pm = r >> 8, gid = pm >> 3, fm = gid * 8, gsz = (36 - fm) < 8 ? (36 - fm) : 8;
#pragma unroll
  for (int k = 0; k < 8; ++k) {
    const int wg = gid * 64 + k * gsz + (pm - fm), off = wg % 36, xcd = wg / 36;
    if (off >= 32) {
      const int j = (off - 32) * 8 + xcd;
      f32x4 v = *(const f32x4*)(rs + 256 * k + 4 * lane) * ALPHA;
      const float* pp = part + (size_t)j * 8 * 65536 + (r & 255) * 256 + 4 * lane;
      f32x4 t[8];
#pragma unroll
      for (int q = 0; q < 8; ++q) t[q] = *(const f32x4*)(pp + (size_t)q * 65536);
#pragma unroll
      for (int q = 0; q < 8; ++q) v += t[q];
      x[k] = v;
    } else x[k] = *(const f32x4*)(s + 256 * k + 4 * lane);
  }
}
__device__ __forceinline__ void ln_finish_row(int r, int lane, f32x4 (&x)[8], float* dstf, bf16_t* dstb, const float* g, const float* bta) {
  float sm = 0.f;
#pragma unroll
  for (int k = 0; k < 8; ++k) sm += x[k][0] + x[k][1] + x[k][2] + x[k][3];
  const float mean = wave_sum(sm) * (1.0f / 2048.0f);
  float q = 0.f;
#pragma unroll
  for (int k = 0; k < 8; ++k) { x[k] = x[k] - mean; q += x[k][0] * x[k][0] + x[k][1] * x[k][1] + x[k][2] * x[k][2] + x[k][3] * x[k][3]; }
  const float rstd = rsqrtf(wave_sum(q) * (1.0f / 2048.0f) + LN_EPS);
#pragma unroll
  for (int k = 0; k < 8; ++k) {
    const int col = 256 * k + 4 * lane;
    const f32x4 gg = *(const f32x4*)(g + col), bb = *(const f32x4*)(bta + col);
    const f32x4 y = x[k] * rstd * gg + bb;
    *(f32x4*)(dstf + (size_t)r * 2048 + col) = y;
    if (dstb) *(u32x2*)(dstb + (size_t)r * 2048 + col) = pack4(y);
  }
}
__device__ __forceinline__ void phase_ln(const Params& p, const float* src, float* dstf, bf16_t* dstb, const float* g, const float* bta, int which) {
  int tid = threadIdx.x; asm volatile("" : "+v"(tid));
  const int w = tid >> 6, lane = tid & 63;
  const int nw = gridDim.x * 8;
  for (int r = blockIdx.x * 8 + w; r < NTOK; r += 2 * nw) {
    const int r2 = r + nw;
    f32x4 xa[8], xb[8];
    ln_load_row(p, src, which, r, lane, xa);
    if (r2 < NTOK) ln_load_row(p, src, which, r2, lane, xb);
    ln_finish_row(r, lane, xa, dstf, dstb, g, bta);
    if (r2 < NTOK) ln_finish_row(r2, lane, xb, dstf, dstb, g, bta);
  }
}

__device__ __forceinline__ void merge_split_reduce(const Params& p) {
  int tid = threadIdx.x; asm volatile("" : "+v"(tid));
  const int j = blockIdx.x >> 3, sl = blockIdx.x & 7;
  int pm, pn; static_tile(36, 8, 256 + j, pm, pn);
  const float* pt = (const float*)(p.ws + WS_PART) + (size_t)j * 8 * 65536 + sl * 8192;
  bf16_t* mb = (bf16_t*)(p.ws + WS_MERGEDB) + ((size_t)pm * 256 + sl * 32) * 2048 + pn * 256;
#pragma unroll
  for (int it = 0; it < 4; ++it) {
    const int e = (it * 512 + tid) * 4, rl = e >> 8, cl = e & 255;
    f32x4 t[8];
#pragma unroll
    for (int q = 0; q < 8; ++q) t[q] = *(const f32x4*)(pt + (size_t)q * 65536 + e);
    f32x4 v = t[0];
#pragma unroll
    for (int q = 1; q < 8; ++q) v += t[q];
    *(u32x2*)(mb + (size_t)rl * 2048 + cl) = pack4(v);
  }
}

__device__ __forceinline__ void ffn_split_reduce(const Params& p) {
  int tid = threadIdx.x; asm volatile("" : "+v"(tid));
  bf16_t* act = (bf16_t*)(p.ws + WS_ACT);
  for (int wk = blockIdx.x; wk < 384; wk += gridDim.x) {
    const int t = wk >> 3, sl = wk & 7;
    int pm, pn; static_tile(36, 44, 1536 + t, pm, pn);
    const float* pt = (const float*)(p.ws + WS_PART) + (size_t)t * 4 * 65536 + sl * 8192;
#pragma unroll
    for (int it = 0; it < 2; ++it) {
      const int idx = it * 512 + tid, rl = idx >> 5, g5 = idx & 31;
      const int bj = g5 >> 4, wc = (g5 >> 2) & 3, lg = g5 & 3;
      const int cl = 128 * bj + 32 * wc + 4 * lg;
      f32x4 tg[4], tu[4];
#pragma unroll
      for (int q = 0; q < 4; ++q) { tg[q] = *(const f32x4*)(pt + (size_t)q * 65536 + rl * 256 + cl); tu[q] = *(const f32x4*)(pt + (size_t)q * 65536 + rl * 256 + cl + 16); }
      const f32x4 g = tg[0] + tg[1] + tg[2] + tg[3], uu = tu[0] + tu[1] + tu[2] + tu[3];
      f32x4 v; v[0] = siluf_(g[0]) * uu[0]; v[1] = siluf_(g[1]) * uu[1]; v[2] = siluf_(g[2]) * uu[2]; v[3] = siluf_(g[3]) * uu[3];
      *(u32x2*)(act + (size_t)(pm * 256 + sl * 32 + rl) * DFF + pn * 128 + 64 * bj + 16 * wc + 4 * lg) = pack4(v);
    }
  }
}

#define XB_TMO      128
#define XB_XCNT(j)  (256  + 64 * (j))
#define XB_XSUB(j)  (1280 + 64 * (j))
#define XB_XGEN(j)  (2304 + 64 * (j))
#define XB_TOP      3328
#define XB_TOPGEN   3392
#define XCD_BAR_WORDS 3456
#define XB_SPIN_CAP (1u << 18)
__device__ __forceinline__ unsigned xb_ld(unsigned* p)              { return __hip_atomic_load(p, __ATOMIC_RELAXED, __HIP_MEMORY_SCOPE_AGENT); }
__device__ __forceinline__ unsigned xb_add(unsigned* p, unsigned v) { return __hip_atomic_fetch_add(p, v, __ATOMIC_RELAXED, __HIP_MEMORY_SCOPE_AGENT); }
__device__ __forceinline__ unsigned xb_xcc_id() { return (unsigned)__builtin_amdgcn_s_getreg((3 << 11) | 20) & 0xFu; }
#define XB_SPIN(cond, bar) do { unsigned _sp = 0; while (cond) { __builtin_amdgcn_s_sleep(1); \
    if ((++_sp & 255u) == 0u) { if (xb_ld(&(bar)[XB_TMO])) break; if (_sp > XB_SPIN_CAP) { atomicAdd(&(bar)[XB_TMO], 1u); break; } } } } while (0)
struct XcdBarrier { unsigned* bar; unsigned x; volatile LAS unsigned* st; };
__device__ __forceinline__ XcdBarrier xcd_barrier_post(unsigned* bar, volatile LAS unsigned* st) {
    XcdBarrier b; b.bar = bar; b.x = xb_xcc_id(); b.st = st;
    if (threadIdx.x == 0) (void)xb_add(&bar[XB_XCNT(b.x)], 1u);
    return b;
}
__device__ __forceinline__ void xcd_barrier_complete(unsigned* bar, unsigned x, unsigned& nloc, unsigned& nx) {
    const unsigned G = gridDim.x * gridDim.y * gridDim.z;
    unsigned sum, cnt, mine, sp = 0u;
    for (;;) {
        sum = 0u; cnt = 0u; mine = 0u;
#pragma unroll
        for (unsigned j = 0; j < 16; ++j) { const unsigned c = xb_ld(&bar[XB_XCNT(j)]); sum += c; cnt += (c > 0u) ? 1u : 0u; mine = (j == x) ? c : mine; }
        if (sum == G) break;
        __builtin_amdgcn_s_sleep(1);
        if ((++sp & 255u) == 0u) { if (xb_ld(&bar[XB_TMO])) break; if (sp > XB_SPIN_CAP) { atomicAdd(&bar[XB_TMO], 1u); break; } }
    }
    nloc = mine > 0u ? mine : 1u; nx = cnt > 0u ? cnt : 1u;
}
__device__ __forceinline__ void xcd_barrier(const XcdBarrier& b) {
    asm volatile("s_waitcnt vmcnt(0)" ::: "memory");
    __syncthreads();
    if (threadIdx.x == 0) {
        unsigned* bar = b.bar;
        __builtin_amdgcn_s_waitcnt(0);
        unsigned nloc = b.st[0], nx = b.st[1];
        if (nloc == 0u) { xcd_barrier_complete(bar, b.x, nloc, nx); b.st[0] = nloc; b.st[1] = nx; }
        const unsigned old = xb_add(&bar[XB_XSUB(b.x)], 1u);
        const unsigned gen = old / nloc;
        if (old + 1u == (gen + 1u) * nloc) {
            __builtin_amdgcn_fence(__ATOMIC_RELEASE, "agent");
            asm volatile("s_waitcnt vmcnt(0)" ::: "memory");
            const unsigned og = xb_add(&bar[XB_TOP], 1u);
            const unsigned tg = og / nx;
            if (og + 1u == (tg + 1u) * nx) xb_add(&bar[XB_TOPGEN], 1u);
            else XB_SPIN(xb_ld(&bar[XB_TOPGEN]) == tg, bar);
            __builtin_amdgcn_fence(__ATOMIC_ACQUIRE, "agent");
            xb_add(&bar[XB_XGEN(b.x)], 1u);
            asm volatile("s_waitcnt vmcnt(0)" ::: "memory");
        } else {
            XB_SPIN(xb_ld(&bar[XB_XGEN(b.x)]) == gen, bar);
            __builtin_amdgcn_fence(__ATOMIC_ACQUIRE, "agent");
            asm volatile("s_waitcnt vmcnt(0)" ::: "memory");
        }
    }
    __syncthreads();
}

__global__ void __launch_bounds__(512, 2) fwd_megakernel(Params p) {
  extern __shared__ __attribute__((aligned(16))) unsigned char shm[];
  LAS unsigned char* lds = (LAS unsigned char*)shm;
  cg::grid_group grid = cg::this_grid();
  unsigned char* ws = p.ws;
  if (p.ph_hi > 1000) grid.sync();
  volatile LAS unsigned* xst = (volatile LAS unsigned*)(lds + LDS_CTL - 16);
  if (threadIdx.x == 0) { xst[0] = 0u; xst[1] = 0u; }
  __syncthreads();
  const XcdBarrier xb = xcd_barrier_post((unsigned*)(ws + WS_BAR), xst);
#ifndef PROBE_PH
#define PROBE_PH -1
#endif
  for (int ph = p.ph_lo; ph < p.ph_hi; ++ph) {
   for (int rep = 0; rep < (ph == PROBE_PH ? 2 : 1); ++rep) {
    if (rep) xcd_barrier(xb);
    if (ph == 1 || ph == 4 || ph == 5 || ph == 7 || ph == 8) {
      const int gph = ph == 1 ? 0 : ph == 4 ? 1 : ph == 5 ? 2 : ph == 7 ? 3 : 4;
      const unsigned ldB = gph == 1 ? 4096u * 2u : gph == 4 ? 5632u * 2u : 2048u * 2u;
      gemm_phase(p, lds, gph, ldB);
      if (gph == 0) conv_queue(p, lds, (unsigned*)(ws + WS_CTL) + 4, 7680, 16384);
      if (gph == 3) conv_queue(p, lds, (unsigned*)(ws + WS_CTL) + 5, 16384, 19200);
      if (gph == 1 && gridDim.x == 256) { xcd_barrier(xb); merge_split_reduce(p); }
      if (gph == 3 && gridDim.x == 256) { xcd_barrier(xb); ffn_split_reduce(p); }
    } else if (ph == 0) phase_prep(p, lds);
    else if (ph == 2) phase_mixers(p, lds, rep);
    else if (ph == 3) phase_retpost(p);
    else if (ph == 6) phase_ln(p, (const float*)(ws + WS_X1), (float*)(ws + WS_X1), (bf16_t*)(ws + WS_X1B), p.in[18], p.in[19], 0);
    else phase_ln(p, (const float*)(ws + WS_YPRE), p.out + O_Y, nullptr, p.in[23], p.in[24], 1);
   }
    if (ph + 1 < p.ph_hi) xcd_barrier(xb);
  }
}

extern "C" void kernel_launch(void* const* d_in, const int* in_sizes, int n_in, void* d_out, int out_size, void* d_ws, size_t ws_size, hipStream_t stream) {
  static int grid_blocks = 0;
  if (grid_blocks == 0) {
    if (n_in != 25 || ws_size < WS_END) { fprintf(stderr, "kernel_launch: unexpected n_in %d or ws_size %zu (need %zu)\n", n_in, ws_size, (size_t)WS_END); grid_blocks = -1; return; }
    int dev = 0, cus = 0, per_cu = 0;
    hipGetDevice(&dev);
    hipDeviceGetAttribute(&cus, hipDeviceAttributeMultiprocessorCount, dev);
    hipFuncSetAttribute((const void*)fwd_megakernel, hipFuncAttributeMaxDynamicSharedMemorySize, LDS_BYTES);
    hipOccupancyMaxActiveBlocksPerMultiprocessor(&per_cu, (const void*)fwd_megakernel, 512, LDS_BYTES);
    if (per_cu < 1) { fprintf(stderr, "kernel_launch: occupancy query returned %d\n", per_cu); per_cu = 1; }
    grid_blocks = cus * per_cu;
    (void)hipGetLastError();
  }
  if (grid_blocks < 0) return;
  if (hipMemsetAsync((char*)d_ws + WS_CTL, 0, WS_CTL_BYTES, stream) != hipSuccess) { fprintf(stderr, "kernel_launch: memset of control words failed\n"); return; }
  Params p{};
  for (int i = 0; i < 25; ++i) p.in[i] = (const float*)d_in[i];
  p.out = (float*)d_out; p.ws = (unsigned char*)d_ws; p.ph_lo = 0; p.ph_hi = 10;
  void* args[] = {&p};
  hipError_t e = hipLaunchCooperativeKernel((const void*)fwd_megakernel, dim3(grid_blocks), dim3(512), args, LDS_BYTES, stream);
  if (e != hipSuccess) fprintf(stderr, "cooperative launch failed: %s (grid %d)\n", hipGetErrorString(e), grid_blocks);
}
```

```cpp
#include <hip/hip_runtime.h>
#include <hip/hip_cooperative_groups.h>
#include <cstdio>
namespace cg = cooperative_groups;

#define LAS __attribute__((address_space(3)))
typedef unsigned short bf16_t;
typedef short bf16x8 __attribute__((ext_vector_type(8)));
typedef short s16x4 __attribute__((ext_vector_type(4)));
typedef float f32x4 __attribute__((ext_vector_type(4)));
typedef unsigned u32x2 __attribute__((ext_vector_type(2)));
typedef unsigned u32x4 __attribute__((ext_vector_type(4)));

constexpr int DM = 2048, NTOK = 9216, TOKP = 8192, INW = 15360, DFF = 5632;
constexpr int OFF_AU = 6144, OFF_AV = 7168, OFF_RQ = 8192, OFF_RK = 9216, OFF_RV = 10240, OFF_RG = 12288, OFF_MQ = 14336;
constexpr float ALPHA = 1.189207115002721f;
constexpr float LN_EPS = 1e-5f;

constexpr size_t al256(size_t x) { return (x + 255) & ~(size_t)255; }
constexpr size_t WS_CTL = 0;
constexpr size_t WS_BAR = 4096;
constexpr size_t WS_CTL_BYTES = 32768;
constexpr size_t WS_ROPE = 32768;
constexpr size_t WS_XB = al256(WS_ROPE + 2056ull * 64 * 2 * 4);
constexpr size_t WS_WIN = WS_XB + (size_t)NTOK * DM * 2;
constexpr size_t WS_WCAT = WS_WIN + (size_t)INW * DM * 2;
constexpr size_t WS_WOUT = WS_WCAT + 2048ull * 4096 * 2;
constexpr size_t WS_WGU = WS_WOUT + 2048ull * 2048 * 2;
constexpr size_t WS_WDN = WS_WGU + 11264ull * 2048 * 2;
constexpr size_t WS_WMKV = WS_WDN + 2048ull * 5632 * 2;
constexpr size_t WS_MEMB = WS_WMKV + 2048ull * 2048 * 2;
constexpr size_t WS_GATES = WS_MEMB + 1024ull * 2048 * 2;
constexpr size_t WS_U = WS_GATES + (size_t)NTOK * 6144 * 2;
constexpr size_t WS_VA = WS_U + (size_t)NTOK * 1024 * 2;
constexpr size_t WS_RQ = WS_VA + (size_t)NTOK * 1024 * 2;
constexpr size_t WS_RK = WS_RQ + (size_t)NTOK * 1024 * 2;
constexpr size_t WS_RV = WS_RK + (size_t)NTOK * 1024 * 2;
constexpr size_t WS_RG = WS_RV + (size_t)NTOK * 2048 * 2;
constexpr size_t WS_MQ = WS_RG + (size_t)NTOK * 2048 * 2;
constexpr size_t WS_MKB = WS_MQ + (size_t)NTOK * 1024 * 2;
constexpr size_t WS_MVB = WS_MKB + 1024ull * 1024 * 2;
constexpr size_t WS_RO = WS_MVB + 1024ull * 1024 * 2;
constexpr size_t WS_PART = WS_RO + 8192ull * 2048 * 2;
constexpr size_t WS_END = WS_PART + 256ull * 65536 * 4;
constexpr size_t WS_ACAT = WS_XB;
constexpr size_t WS_MERGED = WS_U;
constexpr size_t WS_MERGEDB = WS_RV;
constexpr size_t WS_X1 = WS_ACAT;
constexpr size_t WS_X1B = WS_RG;
constexpr size_t WS_ACT = WS_GATES;
constexpr size_t WS_YPRE = WS_MERGED;

constexpr size_t O_Y = 0, O_SRP = 18874368, O_MK = 19922944, O_MV = 20971520, O_SRS = 22020096, O_CV = 55574528;

constexpr int LDS_BYTES = 155648;
constexpr int LDS_CTL = 155632;

struct Params {
  const float* in[25];
  float* out;
  unsigned char* ws;
  int ph_lo, ph_hi;
};

typedef float f32x2 __attribute__((ext_vector_type(2)));
typedef __bf16 bf16x2_t __attribute__((ext_vector_type(2)));
__device__ __forceinline__ unsigned cvt_pk(float lo, float hi) { const f32x2 v = {lo, hi}; const bf16x2_t b = __builtin_convertvector(v, bf16x2_t); return __builtin_bit_cast(unsigned, b); }
__device__ __forceinline__ float bflo(unsigned u) { return __uint_as_float(u << 16); }
__device__ __forceinline__ float bfhi(unsigned u) { return __uint_as_float(u & 0xffff0000u); }
__device__ __forceinline__ u32x2 pack4(f32x4 v) { u32x2 r; r[0] = cvt_pk(v[0], v[1]); r[1] = cvt_pk(v[2], v[3]); return r; }
__device__ __forceinline__ f32x4 unpack4(u32x2 u) { f32x4 r; r[0] = bflo(u[0]); r[1] = bfhi(u[0]); r[2] = bflo(u[1]); r[3] = bfhi(u[1]); return r; }
__device__ __forceinline__ float sigmoidf_(float x) { return __builtin_amdgcn_rcpf(1.0f + __expf(-x)); }
__device__ __forceinline__ float gelu_tanh(float x) { const float z = 1.5957691216057308f * (x + 0.044715f * x * x * x); return x * sigmoidf_(z); }
__device__ __forceinline__ float siluf_(float x) { return x * sigmoidf_(x); }
__device__ __forceinline__ float wave_sum(float v) {
#pragma unroll
  for (int o = 32; o >= 1; o >>= 1) v += __shfl_xor(v, o);
  return v;
}
__device__ __forceinline__ float wave_max(float v) {
#pragma unroll
  for (int o = 32; o >= 1; o >>= 1) v = fmaxf(v, __shfl_xor(v, o));
  return v;
}
typedef short v4i16_t __attribute__((ext_vector_type(4)));
__device__ __forceinline__ s16x4 vtr(const LAS unsigned char* p) { return __builtin_bit_cast(s16x4, __builtin_amdgcn_ds_read_tr16_b64_v4i16((LAS v4i16_t*)p)); }
__device__ __forceinline__ bf16x8 ldfrag(const LAS unsigned char* img, int row, int k, int strideB) { return *(const LAS bf16x8*)(img + row * strideB + k * 2); }
__device__ __forceinline__ bf16x8 ldfrag_tr(const LAS unsigned char* img, int kr0, int kr1, int n0, int strideB, int lane) {
  const int i = lane & 15;
  const LAS unsigned char* a0 = img + (kr0 + (i >> 2)) * strideB + (n0 + 4 * (i & 3)) * 2;
  const LAS unsigned char* a1 = img + (kr1 + (i >> 2)) * strideB + (n0 + 4 * (i & 3)) * 2;
  const s16x4 lo = vtr(a0), hi = vtr(a1);
  return (bf16x8){lo[0], lo[1], lo[2], lo[3], hi[0], hi[1], hi[2], hi[3]};
}
#define MFMA16(a, b, c) __builtin_amdgcn_mfma_f32_16x16x32_bf16((a), (b), (c), 0, 0, 0)

constexpr int BM = 256, BK = 64, HALF = 128, HTB = HALF * BK * 2;
__device__ __forceinline__ int lds_byte(int r, int c) { const int st = (r >> 4) * 2 + (c >> 5), rr = r & 15, cc = c & 31, ob = rr * 64 + cc * 2; return st * 1024 + (ob ^ (((ob >> 9) & 1) << 5)); }
__device__ __forceinline__ void stage_rc(int b, int& R, int& C) { const int st = b / 1024, sb = b % 1024, swz = sb ^ (((sb >> 9) & 1) << 5); R = (st >> 1) * 16 + swz / 64; C = (st & 1) * 32 + (swz % 64) / 2; }

struct Unit { const char* A; const char* B; int nt, pm, pn, kind; };

__device__ __forceinline__ void static_tile(int nM, int nN, int L, int& pm, int& pn) {
  const int nwg = nM * nN; int wgid = L;
  { const int q = nwg / 8, r = nwg % 8, xcd = wgid % 8, off = wgid / 8; wgid = (xcd < r ? xcd * (q + 1) : r * (q + 1) + (xcd - r) * q) + off; }
  const int nig = 8 * nN, gid = wgid / nig, fm = gid * 8, gsz = (nM - fm) < 8 ? (nM - fm) : 8;
  pm = fm + ((wgid % nig) % gsz); pn = (wgid % nig) / gsz;
}

__device__ __forceinline__ bool next_unit(const Params& p, int gph, int i, Unit& u) {
  const int G = gridDim.x, c = blockIdx.x;
  const char* ws = (const char*)p.ws;
  if (gph == 0) {
    const int L = i * G + c;
    if (L < 2160) {
      static_tile(36, 60, L, u.pm, u.pn);
      u.A = ws + WS_XB + (size_t)u.pm * 256 * 2048 * 2; u.B = ws + WS_WIN + (size_t)u.pn * 256 * 2048 * 2; u.nt = 32;
      const int pn = u.pn;
      u.kind = pn < 24 ? 0 : pn < 28 ? 1 : pn < 32 ? 2 : pn < 36 ? 3 : pn < 40 ? 4 : pn < 48 ? 5 : pn < 56 ? 6 : 7;
      return true;
    }
    if (L < 2192) {
      const int mk = L - 2160; u.pm = mk >> 3; u.pn = mk & 7;
      u.A = ws + WS_MEMB + (size_t)u.pm * 256 * 2048 * 2; u.B = ws + WS_WMKV + (size_t)u.pn * 256 * 2048 * 2; u.nt = 32; u.kind = 8;
      return true;
    }
    return false;
  } else if (gph == 1) {
    if (G == 256 && i >= 3) {
      if (i > 3) return false;
      const int su = c, part = su & 7; int pm, pn;
      static_tile(36, 8, 256 + (su >> 3), pm, pn);
      const int seg = part < 2 ? 0 : part < 6 ? 1 : 2;
      const size_t ko = part * 512;
      u.A = ws + WS_ACAT + ((size_t)pm * 256 * 4096 + ko) * 2; u.B = ws + WS_WCAT + ((size_t)pn * 256 * 4096 + ko) * 2;
      u.nt = 8; u.kind = 17 + seg; u.pm = su; u.pn = pm * 8 + pn;
      return true;
    }
    const int L = (i / 3) * G + c, seg = i % 3;
    if (L >= (G == 256 ? 256 : 288)) return false;
    static_tile(36, 8, L, u.pm, u.pn);
    const size_t so = seg == 0 ? 0 : seg == 1 ? 1024 : 3072;
    u.A = ws + WS_ACAT + ((size_t)u.pm * 256 * 4096 + so) * 2; u.B = ws + WS_WCAT + ((size_t)u.pn * 256 * 4096 + so) * 2;
    u.nt = seg == 1 ? 32 : 16; u.kind = 9 + seg;
    return true;
  } else if (gph == 2) {
    const int v = i * G + c; if (v >= 512) return false;
    if (v < 256) {
      static_tile(36, 8, v, u.pm, u.pn);
      u.A = ws + WS_MERGEDB + (size_t)u.pm * 256 * 2048 * 2; u.B = ws + WS_WOUT + (size_t)u.pn * 256 * 2048 * 2; u.nt = 32; u.kind = 12;
    } else {
      const int su = v - 256, s = su & 7; int pm, pn;
      static_tile(36, 8, 256 + (su >> 3), pm, pn);
      u.A = ws + WS_MERGEDB + ((size_t)pm * 256 * 2048 + s * 256) * 2; u.B = ws + WS_WOUT + ((size_t)pn * 256 * 2048 + s * 256) * 2; u.nt = 4; u.kind = 16;
      u.pm = su; u.pn = 0;
    }
    return true;
  } else if (gph == 3) {
    const int L = i * G + c;
    if (G == 256 && L >= 1536) {
      const int su = L - 1536; if (su >= 192) return false;
      int pm, pn; static_tile(36, 44, 1536 + (su >> 2), pm, pn);
      const size_t ko = (size_t)(su & 3) * 512;
      u.A = ws + WS_X1B + ((size_t)pm * 256 * 2048 + ko) * 2; u.B = ws + WS_WGU + ((size_t)pn * 256 * 2048 + ko) * 2; u.nt = 8; u.kind = 16;
      u.pm = su; u.pn = 0;
      return true;
    }
    if (L >= 1584) return false;
    static_tile(36, 44, L, u.pm, u.pn);
    u.A = ws + WS_X1B + (size_t)u.pm * 256 * 2048 * 2; u.B = ws + WS_WGU + (size_t)u.pn * 256 * 2048 * 2; u.nt = 32; u.kind = 13;
    return true;
  } else {
    const int v = i * G + c; if (v >= 512) return false;
    if (v < 256) {
      static_tile(36, 8, v, u.pm, u.pn);
      u.A = ws + WS_ACT + (size_t)u.pm * 256 * 5632 * 2; u.B = ws + WS_WDN + (size_t)u.pn * 256 * 5632 * 2; u.nt = 88; u.kind = 14;
    } else {
      const int su = v - 256, s = su & 7; int pm, pn;
      static_tile(36, 8, 256 + (su >> 3), pm, pn);
      const int kt0 = s < 4 ? 12 * s : 48 + 10 * (s - 4);
      u.A = ws + WS_ACT + ((size_t)pm * 256 * 5632 + kt0 * 64) * 2; u.B = ws + WS_WDN + ((size_t)pn * 256 * 5632 + kt0 * 64) * 2; u.nt = s < 4 ? 12 : 10; u.kind = 16;
      u.pm = su; u.pn = 0;
    }
    return true;
  }
}

__device__ __forceinline__ void epilogue(const Params& p, const Unit& u, const f32x4 (&acc)[2][2][4][2], int wr, int wc, int fr, int fq) {
  unsigned char* ws = p.ws;
  const int row0 = u.pm * 256 + wr * 64 + fr;
  const int ct0 = wc * 32 + 4 * fq;
  const int kind = u.kind;
  if (kind <= 2 || (kind >= 5 && kind <= 7)) {
    bf16_t* dst; int ld, cb, act; float scale = 1.0f;
    if (kind == 0) { dst = (bf16_t*)(ws + WS_GATES); ld = 6144; cb = u.pn * 256; act = 1; }
    else if (kind == 1) { dst = (bf16_t*)(ws + WS_U); ld = 1024; cb = u.pn * 256 - OFF_AU; act = 2; }
    else if (kind == 2) { dst = (bf16_t*)(ws + WS_VA); ld = 1024; cb = u.pn * 256 - OFF_AV; act = 2; }
    else if (kind == 5) { dst = (bf16_t*)(ws + WS_RV); ld = 2048; cb = u.pn * 256 - OFF_RV; act = 0; }
    else if (kind == 6) { dst = (bf16_t*)(ws + WS_RG); ld = 2048; cb = u.pn * 256 - OFF_RG; act = 3; }
    else { dst = (bf16_t*)(ws + WS_MQ); ld = 1024; cb = u.pn * 256 - OFF_MQ; act = 0; scale = 0.0625f; }
#pragma unroll
    for (int ai = 0; ai < 2; ++ai)
#pragma unroll
      for (int m = 0; m < 4; ++m) {
        bf16_t* rp = dst + (size_t)(row0 + ai * 128 + m * 16) * ld + cb + ct0;
#pragma unroll
        for (int bj = 0; bj < 2; ++bj)
#pragma unroll
          for (int n = 0; n < 2; ++n) {
            f32x4 v = acc[ai][bj][m][n];
            if (act == 1) { v[0] = sigmoidf_(v[0]); v[1] = sigmoidf_(v[1]); v[2] = sigmoidf_(v[2]); v[3] = sigmoidf_(v[3]); }
            else if (act == 2) { v[0] = gelu_tanh(v[0]); v[1] = gelu_tanh(v[1]); v[2] = gelu_tanh(v[2]); v[3] = gelu_tanh(v[3]); }
            else if (act == 3) { v[0] = siluf_(v[0]); v[1] = siluf_(v[1]); v[2] = siluf_(v[2]); v[3] = siluf_(v[3]); }
            else { v = v * scale; }
            *(u32x2*)(rp + bj * 128 + n * 16) = pack4(v);
          }
      }
  } else if (kind == 3 || kind == 4) {
    bf16_t* dst = (bf16_t*)(ws + (kind == 3 ? WS_RQ : WS_RK));
    const float scale = kind == 3 ? 1.0f : 0.08838834764831845f;
    const int hb = (u.pn - (kind == 3 ? 32 : 36)) * 2;
    const float* rope = (const float*)(ws + WS_ROPE);
    const int ii = 16 * wc + 4 * fq;
#pragma unroll
    for (int ai = 0; ai < 2; ++ai) {
      f32x4 cs[4][2];
#pragma unroll
      for (int m = 0; m < 4; ++m) {
        const int row = row0 + ai * 128 + m * 16;
        const int pidx = row < TOKP ? (row & 2047) : 2048 + ((row - TOKP) & 7);
        cs[m][0] = *(const f32x4*)(rope + ((size_t)pidx * 64 + ii) * 2);
        cs[m][1] = *(const f32x4*)(rope + ((size_t)pidx * 64 + ii) * 2 + 4);
      }
#pragma unroll
      for (int m = 0; m < 4; ++m) {
        const int row = row0 + ai * 128 + m * 16;
        const f32x4 cs0 = cs[m][0], cs1 = cs[m][1];
#pragma unroll
        for (int bj = 0; bj < 2; ++bj) {
          const f32x4 x1 = acc[ai][bj][m][0] * scale, x2 = acc[ai][bj][m][1] * scale;
          f32x4 o1, o2;
          o1[0] = x1[0] * cs0[0] - x2[0] * cs0[1]; o2[0] = x1[0] * cs0[1] + x2[0] * cs0[0];
          o1[1] = x1[1] * cs0[2] - x2[1] * cs0[3]; o2[1] = x1[1] * cs0[3] + x2[1] * cs0[2];
          o1[2] = x1[2] * cs1[0] - x2[2] * cs1[1]; o2[2] = x1[2] * cs1[1] + x2[2] * cs1[0];
          o1[3] = x1[3] * cs1[2] - x2[3] * cs1[3]; o2[3] = x1[3] * cs1[3] + x2[3] * cs1[2];
          bf16_t* rp = dst + (size_t)row * 1024 + (hb + bj) * 128 + ii;
          *(u32x2*)(rp) = pack4(o1);
          *(u32x2*)(rp + 64) = pack4(o2);
        }
      }
    }
  } else if (kind == 8) {
    const bool isv = u.pn >= 4;
    float* of = p.out + (isv ? O_MV : O_MK);
    bf16_t* ob = (bf16_t*)(ws + (isv ? WS_MVB : WS_MKB));
    const int cb = (u.pn & 3) * 256;
#pragma unroll
    for (int ai = 0; ai < 2; ++ai)
#pragma unroll
      for (int m = 0; m < 4; ++m) {
        const size_t ro = (size_t)(row0 + ai * 128 + m * 16) * 1024 + cb + ct0;
#pragma unroll
        for (int bj = 0; bj < 2; ++bj)
#pragma unroll
          for (int n = 0; n < 2; ++n) {
            const f32x4 v = acc[ai][bj][m][n];
            *(f32x4*)(of + ro + bj * 128 + n * 16) = v;
            *(u32x2*)(ob + ro + bj * 128 + n * 16) = pack4(v);
          }
      }
  } else if (kind >= 9 && kind <= 11) {
    const int seg = kind - 9;
    const bf16_t* gates = (const bf16_t*)(ws + WS_GATES);
    float* mf = (float*)(ws + WS_MERGED);
    bf16_t* mb = (bf16_t*)(ws + WS_MERGEDB);
    const int cb = u.pn * 256 + ct0;
#pragma unroll
    for (int ai = 0; ai < 2; ++ai)
#pragma unroll
      for (int mp = 0; mp < 2; ++mp) {
        u32x2 gr[2][2][2]; f32x4 mv[2][2][2];
#pragma unroll
        for (int mm = 0; mm < 2; ++mm)
#pragma unroll
          for (int bj = 0; bj < 2; ++bj)
#pragma unroll
            for (int n = 0; n < 2; ++n) {
              const size_t row = (size_t)(row0 + ai * 128 + (mp * 2 + mm) * 16);
              const int col = cb + bj * 128 + n * 16;
              gr[mm][bj][n] = *(const u32x2*)(gates + row * 6144 + seg * 2048 + col);
              if (seg > 0) mv[mm][bj][n] = *(const f32x4*)(mf + row * 2048 + col);
            }
#pragma unroll
        for (int mm = 0; mm < 2; ++mm)
#pragma unroll
          for (int bj = 0; bj < 2; ++bj)
#pragma unroll
            for (int n = 0; n < 2; ++n) {
              const size_t row = (size_t)(row0 + ai * 128 + (mp * 2 + mm) * 16);
              const int col = cb + bj * 128 + n * 16;
              f32x4 v = acc[ai][bj][mp * 2 + mm][n] * unpack4(gr[mm][bj][n]);
              if (seg > 0) v += mv[mm][bj][n];
              if (seg < 2) *(f32x4*)(mf + row * 2048 + col) = v;
              else *(u32x2*)(mb + row * 2048 + col) = pack4(v);
            }
      }
  } else if (kind == 12) {
    float* xo = (float*)(ws + WS_X1);
    const int cb = u.pn * 256 + ct0;
#pragma unroll
    for (int ai = 0; ai < 2; ++ai)
#pragma unroll
      for (int mp = 0; mp < 2; ++mp) {
        f32x4 xv[2][2][2];
#pragma unroll
        for (int mm = 0; mm < 2; ++mm) {
          const int row = row0 + ai * 128 + (mp * 2 + mm) * 16;
          const float* xr = row < TOKP ? p.in[0] + (size_t)row * 2048 : p.in[1] + (size_t)(row - TOKP) * 2048;
#pragma unroll
          for (int bj = 0; bj < 2; ++bj)
#pragma unroll
            for (int n = 0; n < 2; ++n) xv[mm][bj][n] = *(const f32x4*)(xr + cb + bj * 128 + n * 16);
        }
#pragma unroll
        for (int mm = 0; mm < 2; ++mm) {
          const int row = row0 + ai * 128 + (mp * 2 + mm) * 16;
#pragma unroll
          for (int bj = 0; bj < 2; ++bj)
#pragma unroll
            for (int n = 0; n < 2; ++n) *(f32x4*)(xo + (size_t)row * 2048 + cb + bj * 128 + n * 16) = xv[mm][bj][n] * ALPHA + acc[ai][bj][mp * 2 + mm][n];
        }
      }
  } else if (kind == 13) {
    bf16_t* act = (bf16_t*)(ws + WS_ACT);
    const int fb = u.pn * 128 + 16 * wc + 4 * fq;
#pragma unroll
    for (int ai = 0; ai < 2; ++ai)
#pragma unroll
      for (int m = 0; m < 4; ++m) {
        const size_t row = (size_t)(row0 + ai * 128 + m * 16);
#pragma unroll
        for (int bj = 0; bj < 2; ++bj) {
          const f32x4 g = acc[ai][bj][m][0], uu = acc[ai][bj][m][1];
          f32x4 v; v[0] = siluf_(g[0]) * uu[0]; v[1] = siluf_(g[1]) * uu[1]; v[2] = siluf_(g[2]) * uu[2]; v[3] = siluf_(g[3]) * uu[3];
          *(u32x2*)(act + row * DFF + fb + bj * 64) = pack4(v);
        }
      }
  } else if (kind >= 17) {
    const int seg = kind - 17;
    const bf16_t* gates = (const bf16_t*)(ws + WS_GATES);
    float* pt = (float*)(ws + WS_PART) + (size_t)u.pm * 65536;
    const int trow = (u.pn >> 3) * 256, tcol = (u.pn & 7) * 256;
#pragma unroll
    for (int ai = 0; ai < 2; ++ai)
#pragma unroll
      for (int mp = 0; mp < 2; ++mp) {
        u32x2 gr[2][2][2];
#pragma unroll
        for (int mm = 0; mm < 2; ++mm)
#pragma unroll
          for (int bj = 0; bj < 2; ++bj)
#pragma unroll
            for (int n = 0; n < 2; ++n) {
              const size_t row = (size_t)(trow + wr * 64 + fr + ai * 128 + (mp * 2 + mm) * 16);
              gr[mm][bj][n] = *(const u32x2*)(gates + row * 6144 + seg * 2048 + tcol + ct0 + bj * 128 + n * 16);
            }
#pragma unroll
        for (int mm = 0; mm < 2; ++mm)
#pragma unroll
          for (int bj = 0; bj < 2; ++bj)
#pragma unroll
            for (int n = 0; n < 2; ++n) {
              const int rl = wr * 64 + fr + ai * 128 + (mp * 2 + mm) * 16;
              *(f32x4*)(pt + rl * 256 + ct0 + bj * 128 + n * 16) = acc[ai][bj][mp * 2 + mm][n] * unpack4(gr[mm][bj][n]);
            }
      }
  } else if (kind == 16) {
    float* pt = (float*)(ws + WS_PART) + (size_t)u.pm * 65536;
#pragma unroll
    for (int ai = 0; ai < 2; ++ai)
#pragma unroll
      for (int m = 0; m < 4; ++m) {
        float* rp = pt + (wr * 64 + fr + ai * 128 + m * 16) * 256 + ct0;
#pragma unroll
        for (int bj = 0; bj < 2; ++bj)
#pragma unroll
          for (int n = 0; n < 2; ++n) *(f32x4*)(rp + bj * 128 + n * 16) = acc[ai][bj][m][n];
      }
  } else {
    const float* x1 = (const float*)(ws + WS_X1);
    float* yo = (float*)(ws + WS_YPRE);
    const int cb = u.pn * 256 + ct0;
#pragma unroll
    for (int ai = 0; ai < 2; ++ai)
#pragma unroll
      for (int mp = 0; mp < 2; ++mp) {
        f32x4 xv[2][2][2];
#pragma unroll
        for (int mm = 0; mm < 2; ++mm) {
          const size_t row = (size_t)(row0 + ai * 128 + (mp * 2 + mm) * 16);
#pragma unroll
          for (int bj = 0; bj < 2; ++bj)
#pragma unroll
            for (int n = 0; n < 2; ++n) xv[mm][bj][n] = *(const f32x4*)(x1 + row * 2048 + cb + bj * 128 + n * 16);
        }
#pragma unroll
        for (int mm = 0; mm < 2; ++mm) {
          const size_t row = (size_t)(row0 + ai * 128 + (mp * 2 + mm) * 16);
#pragma unroll
          for (int bj = 0; bj < 2; ++bj)
#pragma unroll
            for (int n = 0; n < 2; ++n) *(f32x4*)(yo + row * 2048 + cb + bj * 128 + n * 16) = xv[mm][bj][n] * ALPHA + acc[ai][bj][mp * 2 + mm][n];
        }
      }
  }
}

__device__ __forceinline__ void gemm_phase(const Params& p, LAS unsigned char* lds, int gph, unsigned ldB  ) {
  int tid = threadIdx.x; asm volatile("" : "+v"(tid));
  const int wid = __builtin_amdgcn_readfirstlane(tid >> 6), lane = tid & 63, wr = wid >> 2, wc = wid & 3, fr = lane & 15, fq = lane >> 4;
  unsigned voff[2];
#pragma unroll
  for (int i = 0; i < 2; ++i) { int R, C; stage_rc(tid * 16 + i * 8192, R, C); voff[i] = (unsigned)R * ldB + (unsigned)C * 2u; }
  const size_t kstep = (size_t)(BK * 2);
  const size_t hstep = (size_t)HALF * ldB;
  const unsigned ldsw = (unsigned)wid * 1024u;
  const int aoff = lds_byte(wr * 64 + fr, fq * 8), boff = lds_byte(wc * 32 + fr, fq * 8);
#define PG8_SA(b, h) (((b) * 2 + (h)) * HTB)
#define PG8_SB(b, h) ((4 + (b) * 2 + (h)) * HTB)
#define PG8_STAGE(bufoff, gbase) do { _Pragma("unroll") for (int _i = 0; _i < 2; ++_i) \
        __builtin_amdgcn_global_load_lds((const unsigned*)((const char*)(gbase) + voff[_i]), (LAS unsigned*)(lds + (bufoff) + ldsw + _i * 8192), 16, 0, 0); } while (0)
#define PG8_LDA(dst, b, h) do { _Pragma("unroll") for (int m = 0; m < 4; ++m) _Pragma("unroll") for (int k = 0; k < 2; ++k) dst[m][k] = *(const LAS bf16x8*)(lds + PG8_SA(b, h) + aoff + m * 2048 + k * 1024); } while (0)
#define PG8_LDB(dst, b, h) do { _Pragma("unroll") for (int n = 0; n < 2; ++n) _Pragma("unroll") for (int k = 0; k < 2; ++k) dst[n][k] = *(const LAS bf16x8*)(lds + PG8_SB(b, h) + boff + n * 2048 + k * 1024); } while (0)
#define PG8_MMA(ai, bj, At, Bt) do { __builtin_amdgcn_s_setprio(1); _Pragma("unroll") for (int m = 0; m < 4; ++m) _Pragma("unroll") for (int n = 0; n < 2; ++n) _Pragma("unroll") for (int k = 0; k < 2; ++k) \
        acc[ai][bj][m][n] = __builtin_amdgcn_mfma_f32_16x16x32_bf16(Bt[n][k], At[m][k], acc[ai][bj][m][n], 0, 0, 0); __builtin_amdgcn_s_setprio(0); } while (0)
#define PG8_WAIT_V(n) asm volatile("s_waitcnt vmcnt(" #n ")" ::: "memory")
#define PG8_WAIT_L(n) asm volatile("s_waitcnt lgkmcnt(" #n ")" ::: "memory")
#define PG8_BAR __builtin_amdgcn_s_barrier()
#define PG8_SCHED __builtin_amdgcn_sched_barrier(0)
  Unit cur, nxt; int ui = 0;
  if (!next_unit(p, gph, 0, cur)) return;
  f32x4 acc[2][2][4][2];
#pragma unroll
  for (int a = 0; a < 2; ++a)
#pragma unroll
    for (int b = 0; b < 2; ++b)
#pragma unroll
      for (int m = 0; m < 4; ++m)
#pragma unroll
        for (int n = 0; n < 2; ++n) acc[a][b][m][n] = (f32x4){0.f, 0.f, 0.f, 0.f};
  bf16x8 At[4][2], B0[2][2], B1[2][2];
  const char* cA = cur.A; const char* cB = cur.B;
  PG8_STAGE(PG8_SB(0, 0), cB); PG8_STAGE(PG8_SA(0, 0), cA); PG8_STAGE(PG8_SB(0, 1), cB + hstep); PG8_STAGE(PG8_SA(0, 1), cA + hstep);
  if (wr == 1) PG8_BAR;
  PG8_WAIT_V(4); PG8_BAR;
  PG8_STAGE(PG8_SB(1, 0), cB + kstep); PG8_STAGE(PG8_SA(1, 0), cA + kstep); PG8_STAGE(PG8_SB(1, 1), cB + hstep + kstep);
  PG8_WAIT_V(6); PG8_BAR;
  for (;;) {
    const bool has_next = next_unit(p, gph, ui + 1, nxt);
    const char* nA = has_next ? nxt.A : cA; const char* nB = has_next ? nxt.B : cB;
    const int nt = cur.nt;
    for (int t = 0; t < nt; t += 2) {
      const bool last = (t == nt - 2);
      const char* a1 = cA + (size_t)(t + 1) * kstep;
      const char* a2 = last ? nA : cA + (size_t)(t + 2) * kstep; const char* b2 = last ? nB : cB + (size_t)(t + 2) * kstep;
      const char* a3 = a2 + kstep; const char* b3 = b2 + kstep;
      PG8_LDB(B0, 0, 0); PG8_SCHED; PG8_LDA(At, 0, 0); PG8_STAGE(PG8_SA(1, 1), a1 + hstep);
      PG8_WAIT_L(8); PG8_BAR; PG8_WAIT_L(0); PG8_MMA(0, 0, At, B0); PG8_BAR; PG8_SCHED;
      PG8_LDB(B1, 0, 1); PG8_STAGE(PG8_SB(0, 0), b2);
      PG8_BAR; PG8_WAIT_L(0); PG8_MMA(0, 1, At, B1); PG8_BAR;
      PG8_LDA(At, 0, 1); PG8_STAGE(PG8_SA(0, 0), a2);
      PG8_BAR; PG8_WAIT_L(0); PG8_MMA(1, 0, At, B0); PG8_BAR; PG8_SCHED;
      PG8_STAGE(PG8_SB(0, 1), b2 + hstep);
      PG8_WAIT_V(6); PG8_BAR; PG8_MMA(1, 1, At, B1); PG8_BAR;
      PG8_LDB(B0, 1, 0); PG8_SCHED; PG8_LDA(At, 1, 0); PG8_STAGE(PG8_SA(0, 1), a2 + hstep);
      PG8_WAIT_L(8); PG8_BAR; PG8_WAIT_L(0); PG8_MMA(0, 0, At, B0); PG8_BAR; PG8_SCHED;
      PG8_LDB(B1, 1, 1); PG8_STAGE(PG8_SB(1, 0), b3);
      PG8_BAR; PG8_WAIT_L(0); PG8_MMA(0, 1, At, B1); PG8_BAR;
      PG8_LDA(At, 1, 1); PG8_STAGE(PG8_SA(1, 0), a3);
      PG8_BAR; PG8_WAIT_L(0); PG8_MMA(1, 0, At, B0); PG8_BAR; PG8_SCHED;
      PG8_STAGE(PG8_SB(1, 1), b3 + hstep);
      PG8_WAIT_V(6); PG8_BAR; PG8_MMA(1, 1, At, B1); PG8_BAR;
    }
    epilogue(p, cur, acc, wr, wc, fr, fq);
    if (!has_next) break;
#pragma unroll
    for (int a = 0; a < 2; ++a)
#pragma unroll
      for (int b = 0; b < 2; ++b)
#pragma unroll
        for (int m = 0; m < 4; ++m)
#pragma unroll
          for (int n = 0; n < 2; ++n) acc[a][b][m][n] = (f32x4){0.f, 0.f, 0.f, 0.f};
    cur = nxt; cA = nA; cB = nB; ++ui;
  }
  PG8_WAIT_V(0);
  if (wr == 0) PG8_BAR;
  PG8_BAR;
#undef PG8_SA
#undef PG8_SB
#undef PG8_STAGE
#undef PG8_LDA
#undef PG8_LDB
#undef PG8_MMA
#undef PG8_WAIT_V
#undef PG8_WAIT_L
#undef PG8_BAR
#undef PG8_SCHED
}

template <int NT> __device__ __forceinline__ void conv_tilesN(const Params& p, LAS unsigned char* lds, int tid, int t0, int stride, int t_end) {
  unsigned char* ws = p.ws;
  LAS float* tile = (LAS float*)lds;
  const int tx = tid & 63, ty = tid >> 6;
  {
    float v[NT][8];
#pragma unroll
    for (int q = 0; q < NT; ++q) {
      const int t = t0 + q * stride;
      if (t < t_end) {
        int mat, loc, ktn;
        if (t < 7680) { mat = 0; loc = t; ktn = 32; }
        else if (t < 9728) { mat = 1; loc = t - 7680; ktn = 64; }
        else if (t < 10752) { mat = 2; loc = t - 9728; ktn = 32; }
        else if (t < 16384) { mat = 3; loc = t - 10752; ktn = 32; }
        else if (t < 19200) { mat = 4; loc = t - 16384; ktn = 88; }
        else { mat = 5; loc = t - 19200; ktn = 32; }
        const int n0 = (loc / ktn) * 64, k0 = (loc % ktn) * 64;
        const int n = n0 + tx;
        const float* ptr; int ld, col, kk0 = k0;
        if (mat == 0) {
          ptr = p.in[6]; ld = INW; col = n;
          if (n >= OFF_RQ && n < OFF_RV) { const int s = n & 127; col = (n & ~127) + ((s >> 4) & 1) * 64 + (s >> 5) * 16 + (s & 15); }
        } else if (mat == 1) {
          ld = 2048; col = n;
          if (k0 < 1024) { ptr = p.in[11]; } else if (k0 < 3072) { ptr = p.in[13]; kk0 = k0 - 1024; } else { ptr = p.in[16]; kk0 = k0 - 3072; }
        } else if (mat == 2) { ptr = p.in[17]; ld = 2048; col = n; }
        else if (mat == 3) {
          const int T = n >> 8, s = n & 255;
          const int f = 128 * T + 64 * (s >> 7) + 16 * ((s >> 5) & 3) + (s & 15);
          ptr = ((s >> 4) & 1) ? p.in[21] : p.in[20]; ld = DFF; col = f;
        } else if (mat == 4) { ptr = p.in[22]; ld = 2048; col = n; }
        else { if (n < 1024) { ptr = p.in[14]; col = n; } else { ptr = p.in[15]; col = n - 1024; } ld = 1024; }
        const float* s0 = ptr + (size_t)(kk0 + ty * 8) * ld + col;
#pragma unroll
        for (int r = 0; r < 8; ++r) v[q][r] = __builtin_nontemporal_load(s0 + (size_t)r * ld);
      }
    }
#pragma unroll
    for (int q = 0; q < NT; ++q) {
      const int t = t0 + q * stride;
      if (t < t_end) {
        int loc, ktn, ldd; size_t dsto;
        if (t < 7680) { loc = t; ktn = 32; ldd = 2048; dsto = WS_WIN; }
        else if (t < 9728) { loc = t - 7680; ktn = 64; ldd = 4096; dsto = WS_WCAT; }
        else if (t < 10752) { loc = t - 9728; ktn = 32; ldd = 2048; dsto = WS_WOUT; }
        else if (t < 16384) { loc = t - 10752; ktn = 32; ldd = 2048; dsto = WS_WGU; }
        else if (t < 19200) { loc = t - 16384; ktn = 88; ldd = 5632; dsto = WS_WDN; }
        else { loc = t - 19200; ktn = 32; ldd = 2048; dsto = WS_WMKV; }
        const int n0 = (loc / ktn) * 64, k0 = (loc % ktn) * 64;
        __syncthreads();
#pragma unroll
        for (int r = 0; r < 8; ++r) tile[(ty * 8 + r) * 65 + tx] = v[q][r];
        __syncthreads();
        const int nn = tid >> 3, kc = (tid & 7) * 8;
        float w[8];
#pragma unroll
        for (int e = 0; e < 8; ++e) w[e] = tile[(kc + e) * 65 + nn];
        u32x4 o; o[0] = cvt_pk(w[0], w[1]); o[1] = cvt_pk(w[2], w[3]); o[2] = cvt_pk(w[4], w[5]); o[3] = cvt_pk(w[6], w[7]);
        __builtin_nontemporal_store(o, (u32x4*)((bf16_t*)(ws + dsto) + (size_t)(n0 + nn) * ldd + k0 + kc));
      }
    }
  }
}

__device__ __forceinline__ void phase_prep(const Params& p, LAS unsigned char* lds) {
  int tid = threadIdx.x; asm volatile("" : "+v"(tid));
  unsigned char* ws = p.ws;
  if (blockIdx.x == 0 && tid < 16) { ((unsigned*)(ws + WS_CTL))[tid] = 0u; }
  {
    float* rope = (float*)(ws + WS_ROPE);
    for (int idx = blockIdx.x * 512 + tid; idx < 2056 * 64; idx += gridDim.x * 512) {
      const int pidx = idx >> 6, i = idx & 63;
      const double pos = pidx < 2048 ? (double)pidx : (double)(16384 + (pidx - 2048));
      double inv = 1.0; for (int k = 0; k < i; ++k) inv *= 0.8659643233600653;
      double rev = pos * inv * 0.15915494309189535;
      rev -= floor(rev);
      const float fr = (float)rev;
      rope[(size_t)idx * 2] = __builtin_amdgcn_cosf(fr);
      rope[(size_t)idx * 2 + 1] = __builtin_amdgcn_sinf(fr);
    }
  }
  {
    const int NCH_X = NTOK * DM / 8, NCH_M = 1024 * 2048 / 8, NCH = NCH_X + NCH_M;
    for (int ch0 = (blockIdx.x * 512 + tid); ch0 < NCH; ch0 += gridDim.x * 512 * 4) {
      f32x4 a[4], b[4];
#pragma unroll
      for (int q = 0; q < 4; ++q) {
        const int ch = ch0 + q * (int)gridDim.x * 512;
        if (ch < NCH) {
          const float* src = ch < TOKP * DM / 8 ? p.in[0] + (size_t)ch * 8 : ch < NCH_X ? p.in[1] + (size_t)(ch - TOKP * DM / 8) * 8 : p.in[2] + (size_t)(ch - NCH_X) * 8;
          a[q] = __builtin_nontemporal_load((const f32x4*)src); b[q] = __builtin_nontemporal_load((const f32x4*)(src + 4));
        }
      }
#pragma unroll
      for (int q = 0; q < 4; ++q) {
        const int ch = ch0 + q * (int)gridDim.x * 512;
        if (ch < NCH) {
          bf16_t* dst = ch < NCH_X ? (bf16_t*)(ws + WS_XB) + (size_t)ch * 8 : (bf16_t*)(ws + WS_MEMB) + (size_t)(ch - NCH_X) * 8;
          u32x4 o; o[0] = cvt_pk(a[q][0], a[q][1]); o[1] = cvt_pk(a[q][2], a[q][3]); o[2] = cvt_pk(b[q][0], b[q][1]); o[3] = cvt_pk(b[q][2], b[q][3]);
          *(u32x4*)dst = o;
        }
      }
    }
  }
  for (int tb = blockIdx.x; tb < 7680; tb += 8 * gridDim.x) conv_tilesN<8>(p, lds, tid, tb, (int)gridDim.x, 7680);
  for (int tb = 19200 + blockIdx.x; tb < 20224; tb += 4 * gridDim.x) conv_tilesN<4>(p, lds, tid, tb, (int)gridDim.x, 20224);
  __syncthreads();
}

__device__ __forceinline__ void conv_queue(const Params& p, LAS unsigned char* lds, unsigned* ctr, int t_begin, int t_end) {
  int tid = threadIdx.x; asm volatile("" : "+v"(tid));
  LAS unsigned* slot = (LAS unsigned*)(lds + LDS_CTL);
  unsigned nxt = 0u;
  if (tid == 0) nxt = atomicAdd(ctr, 4u);
  for (;;) {
    __syncthreads();
    if (tid == 0) *slot = nxt;
    __syncthreads();
    const int base = t_begin + (int)__builtin_amdgcn_readfirstlane(*slot);
    if (base >= t_end) break;
    if (tid == 0) nxt = atomicAdd(ctr, 4u);
    conv_tilesN<4>(p, lds, tid, base, 1, t_end);
  }
}

__device__ __forceinline__ float ret_lg(int h) { return log1pf(-exp2f(-5.0f - (float)h)); }

__device__ __forceinline__ void mix_ret_prompt(const Params& p, LAS unsigned char* lds, int u) {
  int tid = threadIdx.x; asm volatile("" : "+v"(tid)); const int w = tid >> 6, lane = tid & 63, fr = lane & 15, fq = lane >> 4;
  const int b = u >> 5, h = (u >> 2) & 7, es = u & 3;
  unsigned char* ws = p.ws;
  const bf16_t* RQ = (const bf16_t*)(ws + WS_RQ); const bf16_t* RK = (const bf16_t*)(ws + WS_RK); const bf16_t* RV = (const bf16_t*)(ws + WS_RV);
  bf16_t* RO = (bf16_t*)(ws + WS_RO);
  LAS unsigned char* Qi = lds;
  LAS unsigned char* Ki = lds + 34816;
  LAS unsigned char* Vi = lds + 69632;
  LAS unsigned char* Si = lds + 88064;
  const float lg = ret_lg(h);
  const float cd = __expf(128.0f * lg);
  const int irow = 16 * w + fr;
  const float sa = __expf((float)(irow - 127) * lg), sb = __expf((float)(irow + 1) * lg);
  f32x4 accS[4];
#pragma unroll
  for (int n = 0; n < 4; ++n) accS[n] = (f32x4){0.f, 0.f, 0.f, 0.f};
  u32x4 nq[4], nk[4], nv[2];
#pragma unroll
  for (int it = 0; it < 4; ++it) {
    const int ch = tid + it * 512, row = ch >> 4, cc = ch & 15;
    nq[it] = *(const u32x4*)(RQ + (size_t)(b * 2048 + row) * 1024 + h * 128 + cc * 8);
    nk[it] = *(const u32x4*)(RK + (size_t)(b * 2048 + row) * 1024 + h * 128 + cc * 8);
  }
#pragma unroll
  for (int it = 0; it < 2; ++it) {
    const int ch = tid + it * 512, row = ch >> 3, cc = ch & 7;
    nv[it] = *(const u32x4*)(RV + (size_t)(b * 2048 + row) * 2048 + h * 256 + es * 64 + cc * 8);
  }
  for (int c = 0; c < 16; ++c) {
    const int t0 = b * 2048 + c * 128;
    __syncthreads();
#pragma unroll
    for (int it = 0; it < 4; ++it) {
      const int ch = tid + it * 512, row = ch >> 4, cc = ch & 15;
      *(LAS u32x4*)(Qi + row * 272 + cc * 16) = nq[it];
      *(LAS u32x4*)(Ki + row * 272 + cc * 16) = nk[it];
    }
#pragma unroll
    for (int it = 0; it < 2; ++it) {
      const int ch = tid + it * 512, row = ch >> 3, cc = ch & 7;
      const u32x4 vv = nv[it];
      const float sc = __expf((float)(127 - row) * lg);
      u32x4 o;
#pragma unroll
      for (int e = 0; e < 4; ++e) o[e] = cvt_pk(bflo(vv[e]) * sc, bfhi(vv[e]) * sc);
      *(LAS u32x4*)(Vi + row * 144 + cc * 16) = o;
    }
#pragma unroll
    for (int n = 0; n < 4; ++n) *(LAS u32x2*)(Si + irow * 144 + (16 * n + 4 * fq) * 2) = pack4(accS[n]);
    if (c + 1 < 16) {
      const int t1 = t0 + 128;
#pragma unroll
      for (int it = 0; it < 4; ++it) {
        const int ch = tid + it * 512, row = ch >> 4, cc = ch & 15;
        nq[it] = *(const u32x4*)(RQ + (size_t)(t1 + row) * 1024 + h * 128 + cc * 8);
        nk[it] = *(const u32x4*)(RK + (size_t)(t1 + row) * 1024 + h * 128 + cc * 8);
      }
#pragma unroll
      for (int it = 0; it < 2; ++it) {
        const int ch = tid + it * 512, row = ch >> 3, cc = ch & 7;
        nv[it] = *(const u32x4*)(RV + (size_t)(t1 + row) * 2048 + h * 256 + es * 64 + cc * 8);
      }
    }
    __syncthreads();
    bf16x8 Qf[4];
#pragma unroll
    for (int ks = 0; ks < 4; ++ks) Qf[ks] = ldfrag(Qi, irow, 32 * ks + 8 * fq, 272);
    f32x4 sc8[8];
#pragma unroll
    for (int nt = 0; nt < 8; ++nt) {
      sc8[nt] = (f32x4){0.f, 0.f, 0.f, 0.f};
#pragma unroll
      for (int ks = 0; ks < 4; ++ks) sc8[nt] = MFMA16(ldfrag(Ki, 16 * nt + fr, 32 * ks + 8 * fq, 272), Qf[ks], sc8[nt]);
#pragma unroll
      for (int j = 0; j < 4; ++j) if (16 * nt + 4 * fq + j > irow) sc8[nt][j] = 0.f;
    }
    bf16x8 Pf[4];
#pragma unroll
    for (int k2 = 0; k2 < 4; ++k2) {
      const u32x2 lo = pack4(sc8[2 * k2]), hi = pack4(sc8[2 * k2 + 1]);
      const u32x4 t = (u32x4){lo[0], lo[1], hi[0], hi[1]};
      Pf[k2] = __builtin_bit_cast(bf16x8, t);
    }
    bf16x8 Vf[4][4];
#pragma unroll
    for (int n = 0; n < 4; ++n)
#pragma unroll
      for (int k2 = 0; k2 < 4; ++k2) Vf[n][k2] = ldfrag_tr(Vi, 32 * k2 + 4 * fq, 32 * k2 + 16 + 4 * fq, 16 * n, 144, lane);
#pragma unroll
    for (int n = 0; n < 4; ++n) {
      f32x4 aA = (f32x4){0.f, 0.f, 0.f, 0.f}, aB = (f32x4){0.f, 0.f, 0.f, 0.f};
#pragma unroll
      for (int k2 = 0; k2 < 4; ++k2) aA = MFMA16(Vf[n][k2], Pf[k2], aA);
#pragma unroll
      for (int ks = 0; ks < 4; ++ks) aB = MFMA16(ldfrag_tr(Si, 32 * ks + 8 * fq, 32 * ks + 8 * fq + 4, 16 * n, 144, lane), Qf[ks], aB);
      const f32x4 o = aA * sa + aB * sb;
      *(u32x2*)(RO + (size_t)(t0 + irow) * 2048 + h * 256 + es * 64 + 16 * n + 4 * fq) = pack4(o);
    }
    bf16x8 Kt[4];
#pragma unroll
    for (int k2 = 0; k2 < 4; ++k2) Kt[k2] = ldfrag_tr(Ki, 32 * k2 + 4 * fq, 32 * k2 + 16 + 4 * fq, 16 * w, 272, lane);
#pragma unroll
    for (int n = 0; n < 4; ++n) {
      accS[n] = accS[n] * cd;
#pragma unroll
      for (int k2 = 0; k2 < 4; ++k2) accS[n] = MFMA16(Vf[n][k2], Kt[k2], accS[n]);
    }
  }
  float* so = p.out + O_SRP + ((size_t)(b * 8 + h) * 128 + irow) * 256 + es * 64;
#pragma unroll
  for (int n = 0; n < 4; ++n) *(f32x4*)(so + 16 * n + 4 * fq) = accS[n];
}

__device__ __forceinline__ void mix_ret_sample(const Params& p, LAS unsigned char* lds, int u) {
  int tid = threadIdx.x; asm volatile("" : "+v"(tid)); const int w = tid >> 6, lane = tid & 63;
  const int b = u >> 3, h = u & 7;
  unsigned char* ws = p.ws;
  const bf16_t* RQ = (const bf16_t*)(ws + WS_RQ); const bf16_t* RK = (const bf16_t*)(ws + WS_RK); const bf16_t* RV = (const bf16_t*)(ws + WS_RV);
  const bf16_t* RG = (const bf16_t*)(ws + WS_RG);
  bf16_t* ACAT = (bf16_t*)(ws + WS_ACAT);
  LAS float* qT = (LAS float*)lds;
  LAS float* kT = (LAS float*)(lds + 4096);
  LAS float* scs = (LAS float*)(lds + 8192);
  LAS float* red = (LAS float*)(lds + 8704);
  const float lg = ret_lg(h);
  const int r0 = TOKP + 8 * b;
  f32x4 s0v[16];
  {
    const float* S0p = p.in[3] + ((size_t)(b * 8 + h) * 128 + 16 * w) * 256 + 4 * lane;
#pragma unroll
    for (int dd = 0; dd < 16; ++dd) s0v[dd] = __builtin_nontemporal_load((const f32x4*)(S0p + dd * 256));
  }
  __syncthreads();
  for (int idx = tid; idx < 1024; idx += 512) {
    const int i = idx >> 7, d = idx & 127;
    qT[d * 8 + i] = bflo((unsigned)RQ[(size_t)(r0 + i) * 1024 + h * 128 + d]);
    kT[d * 8 + i] = bflo((unsigned)RK[(size_t)(r0 + i) * 1024 + h * 128 + d]) * __expf((float)(7 - i) * lg);
  }
  const int e4 = 4 * lane;
  f32x4 vv[8];
#pragma unroll
  for (int j = 0; j < 8; ++j) vv[j] = unpack4(*(const u32x2*)(RV + (size_t)(r0 + j) * 2048 + h * 256 + e4));
  __syncthreads();
  if (tid < 64) {
    const int i = tid >> 3, j = tid & 7;
    float s = 0.f;
    for (int d = 0; d < 128; ++d) s += qT[d * 8 + i] * kT[d * 8 + j];
    scs[tid] = j <= i ? s * __expf((float)(i - 7) * lg) : 0.f;
  }
  const float cd = __expf(8.0f * lg);
  f32x4 acc[8];
#pragma unroll
  for (int i = 0; i < 8; ++i) acc[i] = (f32x4){0.f, 0.f, 0.f, 0.f};
  const float* S0 = p.in[3] + ((size_t)(b * 8 + h) * 128 + 16 * w) * 256 + e4;
  float* S1 = p.out + O_SRS + ((size_t)(b * 8 + h) * 128 + 16 * w) * 256 + e4;
#pragma unroll
  for (int dd = 0; dd < 16; ++dd) {
    const int d = 16 * w + dd;
    const f32x4 s0 = s0v[dd];
    const f32x4 qa = *(const LAS f32x4*)(qT + d * 8), qb = *(const LAS f32x4*)(qT + d * 8 + 4);
    const f32x4 ka = *(const LAS f32x4*)(kT + d * 8), kb = *(const LAS f32x4*)(kT + d * 8 + 4);
    acc[0] += s0 * qa[0]; acc[1] += s0 * qa[1]; acc[2] += s0 * qa[2]; acc[3] += s0 * qa[3];
    acc[4] += s0 * qb[0]; acc[5] += s0 * qb[1]; acc[6] += s0 * qb[2]; acc[7] += s0 * qb[3];
    f32x4 sn = s0 * cd;
    sn += vv[0] * ka[0]; sn += vv[1] * ka[1]; sn += vv[2] * ka[2]; sn += vv[3] * ka[3];
    sn += vv[4] * kb[0]; sn += vv[5] * kb[1]; sn += vv[6] * kb[2]; sn += vv[7] * kb[3];
    __builtin_nontemporal_store(sn, (f32x4*)(S1 + dd * 256));
  }
#pragma unroll
  for (int i = 0; i < 8; ++i) *(LAS f32x4*)(red + (w * 8 + i) * 256 + e4) = acc[i];
  __syncthreads();
  {
    const int i = w;
    f32x4 o = (f32x4){0.f, 0.f, 0.f, 0.f};
#pragma unroll
    for (int ww = 0; ww < 8; ++ww) o += *(const LAS f32x4*)(red + (ww * 8 + i) * 256 + e4);
    o = o * __expf((float)(i + 1) * lg);
#pragma unroll
    for (int j = 0; j < 8; ++j) o += vv[j] * scs[i * 8 + j];
    const float mean = wave_sum(o[0] + o[1] + o[2] + o[3]) * (1.0f / 256.0f);
    const f32x4 dlt = o - mean;
    const float var = wave_sum(dlt[0] * dlt[0] + dlt[1] * dlt[1] + dlt[2] * dlt[2] + dlt[3] * dlt[3]) * (1.0f / 256.0f);
    const float rstd = rsqrtf(var + LN_EPS);
    const f32x4 gn = *(const f32x4*)(p.in[12] + h * 256 + e4);
    const f32x4 sg = unpack4(*(const u32x2*)(RG + (size_t)(r0 + i) * 2048 + h * 256 + e4));
    const f32x4 r = dlt * rstd * gn * sg;
    *(u32x2*)(ACAT + (size_t)(r0 + i) * 4096 + 1024 + h * 256 + e4) = pack4(r);
  }
}

__device__ __forceinline__ void mix_sg_prompt(const Params& p, LAS unsigned char* lds, int u) {
  int tid = threadIdx.x; asm volatile("" : "+v"(tid)); const int w = tid >> 6, lane = tid & 63, fr = lane & 15, fq = lane >> 4;
  const int b = u >> 6, c = (u >> 2) & 15, g = u & 3;
  unsigned char* ws = p.ws;
  const bf16_t* VA = (const bf16_t*)(ws + WS_VA); const bf16_t* U = (const bf16_t*)(ws + WS_U);
  bf16_t* ACAT = (bf16_t*)(ws + WS_ACAT);
  LAS unsigned char* Vs = lds;
  LAS unsigned char* Wsm = lds + 67584;
  const int t0 = b * 2048 + c * 128;
  __syncthreads();
  {
    const int row = tid >> 2, part = tid & 3;
    const bf16_t* src = VA + (size_t)(t0 + row) * 1024 + g * 256;
    u32x4 raw[8];
#pragma unroll
    for (int k = 0; k < 8; ++k) raw[k] = *(const u32x4*)(src + (part + 4 * k) * 8);
    float s = 0.f;
#pragma unroll
    for (int k = 0; k < 8; ++k)
#pragma unroll
      for (int e = 0; e < 4; ++e) s += bflo(raw[k][e]) + bfhi(raw[k][e]);
    s += __shfl_xor(s, 1); s += __shfl_xor(s, 2);
    const float mean = s * (1.0f / 256.0f);
    float q = 0.f;
#pragma unroll
    for (int k = 0; k < 8; ++k)
#pragma unroll
      for (int e = 0; e < 4; ++e) { const float a = bflo(raw[k][e]) - mean, bb = bfhi(raw[k][e]) - mean; q += a * a + bb * bb; }
    q += __shfl_xor(q, 1); q += __shfl_xor(q, 2);
    const float rstd = rsqrtf(q * (1.0f / 256.0f) + LN_EPS);
    const float* lng = p.in[7] + g * 256; const float* lnb = p.in[8] + g * 256;
#pragma unroll
    for (int k = 0; k < 8; ++k) {
      const int col = (part + 4 * k) * 8;
      const f32x4 g0 = *(const f32x4*)(lng + col), g1 = *(const f32x4*)(lng + col + 4);
      const f32x4 b0 = *(const f32x4*)(lnb + col), b1 = *(const f32x4*)(lnb + col + 4);
      u32x4 o;
      o[0] = cvt_pk((bflo(raw[k][0]) - mean) * rstd * g0[0] + b0[0], (bfhi(raw[k][0]) - mean) * rstd * g0[1] + b0[1]);
      o[1] = cvt_pk((bflo(raw[k][1]) - mean) * rstd * g0[2] + b0[2], (bfhi(raw[k][1]) - mean) * rstd * g0[3] + b0[3]);
      o[2] = cvt_pk((bflo(raw[k][2]) - mean) * rstd * g1[0] + b1[0], (bfhi(raw[k][2]) - mean) * rstd * g1[1] + b1[1]);
      o[3] = cvt_pk((bflo(raw[k][3]) - mean) * rstd * g1[2] + b1[2], (bfhi(raw[k][3]) - mean) * rstd * g1[3] + b1[3]);
      *(LAS u32x4*)(Vs + row * 528 + col * 2) = o;
    }
    const float* wsrc = p.in[9] + ((size_t)g * 128 + row) * 128 + part * 32;
#pragma unroll
    for (int k = 0; k < 4; ++k) {
      const f32x4 a = *(const f32x4*)(wsrc + k * 8), bb = *(const f32x4*)(wsrc + k * 8 + 4);
      const int j0 = part * 32 + k * 8;
      float v[8] = {a[0], a[1], a[2], a[3], bb[0], bb[1], bb[2], bb[3]};
#pragma unroll
      for (int e = 0; e < 8; ++e) if (j0 + e > row) v[e] = 0.f;
      u32x4 o; o[0] = cvt_pk(v[0], v[1]); o[1] = cvt_pk(v[2], v[3]); o[2] = cvt_pk(v[4], v[5]); o[3] = cvt_pk(v[6], v[7]);
      *(LAS u32x4*)(Wsm + row * 272 + j0 * 2) = o;
    }
  }
  __syncthreads();
  const int irow = 16 * w + fr;
  f32x4 acc[16];
#pragma unroll
  for (int n = 0; n < 16; ++n) acc[n] = (f32x4){0.f, 0.f, 0.f, 0.f};
#pragma unroll
  for (int ks = 0; ks < 4; ++ks) {
    const bf16x8 Af = ldfrag(Wsm, irow, 32 * ks + 8 * fq, 272);
#pragma unroll
    for (int n = 0; n < 16; ++n) acc[n] = MFMA16(ldfrag_tr(Vs, 32 * ks + 8 * fq, 32 * ks + 8 * fq + 4, 16 * n, 528, lane), Af, acc[n]);
  }
  const float bias = p.in[10][g * 128 + irow];
#pragma unroll
  for (int n = 0; n < 16; ++n) {
    const int d = 16 * n + 4 * fq;
    const f32x4 uu = unpack4(*(const u32x2*)(U + (size_t)(t0 + irow) * 1024 + g * 256 + d));
    const f32x4 o = uu * (acc[n] + bias);
    *(u32x2*)(ACAT + (size_t)(t0 + irow) * 4096 + g * 256 + d) = pack4(o);
  }
}

__device__ __forceinline__ void mix_sg_sample(const Params& p, LAS unsigned char* lds, int b) {
  int tid = threadIdx.x; asm volatile("" : "+v"(tid)); const int w = tid >> 6, lane = tid & 63;
  unsigned char* ws = p.ws;
  const bf16_t* VA = (const bf16_t*)(ws + WS_VA); const bf16_t* U = (const bf16_t*)(ws + WS_U);
  bf16_t* ACAT = (bf16_t*)(ws + WS_ACAT);
  LAS float* vs = (LAS float*)lds;
  const int r0 = TOKP + 8 * b;
  __syncthreads();
#pragma unroll
  for (int g = 0; g < 4; ++g) {
    const int col = g * 256 + 4 * lane;
    const f32x4 x = unpack4(*(const u32x2*)(VA + (size_t)(r0 + w) * 1024 + col));
    const float mean = wave_sum(x[0] + x[1] + x[2] + x[3]) * (1.0f / 256.0f);
    const f32x4 d = x - mean;
    const float var = wave_sum(d[0] * d[0] + d[1] * d[1] + d[2] * d[2] + d[3] * d[3]) * (1.0f / 256.0f);
    const float rstd = rsqrtf(var + LN_EPS);
    const f32x4 gg = *(const f32x4*)(p.in[7] + col), bb = *(const f32x4*)(p.in[8] + col);
    const f32x4 va = d * rstd * gg + bb;
    *(f32x4*)(p.out + O_CV + (size_t)(b * 8 + w) * 1024 + col) = va;
    *(LAS f32x4*)(vs + w * 1024 + col) = va;
  }
  __syncthreads();
#pragma unroll
  for (int g = 0; g < 4; ++g) {
    const int col = g * 256 + 4 * lane;
    const float bias = p.in[10][g * 128 + w];
    f32x4 z = (f32x4){bias, bias, bias, bias};
    for (int j = 0; j <= w; ++j) {
      const float wv = p.in[9][((size_t)g * 128 + w) * 128 + j];
      z += *(const LAS f32x4*)(vs + j * 1024 + col) * wv;
    }
    const f32x4 uu = unpack4(*(const u32x2*)(U + (size_t)(r0 + w) * 1024 + col));
    *(u32x2*)(ACAT + (size_t)(r0 + w) * 4096 + col) = pack4(uu * z);
  }
}

__device__ __forceinline__ void mix_ma_prompt(const Params& p, LAS unsigned char* lds, int u) {
  int tid = threadIdx.x; asm volatile("" : "+v"(tid)); const int w = tid >> 6, lane = tid & 63, fr = lane & 15, fq = lane >> 4;
  const int b = u >> 6, h = (u >> 4) & 3, qt = u & 15;
  unsigned char* ws = p.ws;
  const bf16_t* MQ = (const bf16_t*)(ws + WS_MQ); const bf16_t* MK = (const bf16_t*)(ws + WS_MKB); const bf16_t* MV = (const bf16_t*)(ws + WS_MVB);
  bf16_t* ACAT = (bf16_t*)(ws + WS_ACAT);
  LAS unsigned char* KV = lds;
  const int irow = b * 2048 + qt * 128 + 16 * w + fr;
  __syncthreads();
#pragma unroll
  for (int it = 0; it < 16; ++it) {
    const int ch = tid + it * 512, row = ch >> 5, cc = ch & 31;
    *(LAS u32x4*)(KV + row * 528 + cc * 16) = *(const u32x4*)(MK + (size_t)(b * 256 + row) * 1024 + h * 256 + cc * 8);
  }
  bf16x8 Qf[8];
#pragma unroll
  for (int ks = 0; ks < 8; ++ks) Qf[ks] = *(const bf16x8*)(MQ + (size_t)irow * 1024 + h * 256 + 32 * ks + 8 * fq);
  __syncthreads();
  f32x4 s[16];
#pragma unroll
  for (int n = 0; n < 16; ++n) {
    s[n] = (f32x4){0.f, 0.f, 0.f, 0.f};
#pragma unroll
    for (int ks = 0; ks < 8; ++ks) s[n] = MFMA16(ldfrag(KV, 16 * n + fr, 32 * ks + 8 * fq, 528), Qf[ks], s[n]);
  }
  float mx = -3.0e38f;
#pragma unroll
  for (int n = 0; n < 16; ++n) mx = fmaxf(mx, fmaxf(fmaxf(s[n][0], s[n][1]), fmaxf(s[n][2], s[n][3])));
  mx = fmaxf(mx, __shfl_xor(mx, 16)); mx = fmaxf(mx, __shfl_xor(mx, 32));
  float sum = 0.f;
#pragma unroll
  for (int n = 0; n < 16; ++n)
#pragma unroll
    for (int j = 0; j < 4; ++j) { const float e = __expf(s[n][j] - mx); s[n][j] = e; sum += e; }
  sum += __shfl_xor(sum, 16); sum += __shfl_xor(sum, 32);
  const float inv = 1.0f / sum;
  bf16x8 Pf[8];
#pragma unroll
  for (int k2 = 0; k2 < 8; ++k2) {
    const u32x2 lo = pack4(s[2 * k2]), hi = pack4(s[2 * k2 + 1]);
    const u32x4 t = (u32x4){lo[0], lo[1], hi[0], hi[1]};
    Pf[k2] = __builtin_bit_cast(bf16x8, t);
  }
  __syncthreads();
#pragma unroll
  for (int it = 0; it < 16; ++it) {
    const int ch = tid + it * 512, row = ch >> 5, cc = ch & 31;
    *(LAS u32x4*)(KV + row * 528 + cc * 16) = *(const u32x4*)(MV + (size_t)(b * 256 + row) * 1024 + h * 256 + cc * 8);
  }
  __syncthreads();
#pragma unroll
  for (int n = 0; n < 16; ++n) {
    f32x4 o = (f32x4){0.f, 0.f, 0.f, 0.f};
#pragma unroll
    for (int k2 = 0; k2 < 8; ++k2) o = MFMA16(ldfrag_tr(KV, 32 * k2 + 4 * fq, 32 * k2 + 16 + 4 * fq, 16 * n, 528, lane), Pf[k2], o);
    *(u32x2*)(ACAT + (size_t)irow * 4096 + 3072 + h * 256 + 16 * n + 4 * fq) = pack4(o * inv);
  }
}

__device__ __forceinline__ void mix_ma_sample(const Params& p, LAS unsigned char* lds, int u) {
  int tid = threadIdx.x; asm volatile("" : "+v"(tid)); const int w = tid >> 6, lane = tid & 63, fr = lane & 15, fq = lane >> 4;
  const int b = u >> 2, h = u & 3;
  unsigned char* ws = p.ws;
  const bf16_t* MQ = (const bf16_t*)(ws + WS_MQ);
  bf16_t* ACAT = (bf16_t*)(ws + WS_ACAT);
  LAS unsigned char* KV = lds;
  LAS float* Sc = (LAS float*)(lds + 135168);
  LAS unsigned char* Pb = lds + 135168 + 8192;
  const int r0 = TOKP + 8 * b;
  const float* Kc = p.in[4] + ((size_t)b * 256 * 4 + h) * 256;
  const float* Vc = p.in[5] + ((size_t)b * 256 * 4 + h) * 256;
  __syncthreads();
  bf16x8 Qf[8];
#pragma unroll
  for (int ks = 0; ks < 8; ++ks) Qf[ks] = *(const bf16x8*)(MQ + (size_t)(r0 + (fr & 7)) * 1024 + h * 256 + 32 * ks + 8 * fq);
#pragma unroll 1
  for (int it0 = 0; it0 < 32; it0 += 16) {
    f32x4 t[16];
#pragma unroll
    for (int k = 0; k < 16; ++k) { const int ch = tid + (it0 + k) * 512, row = ch >> 6, cc = ch & 63; t[k] = __builtin_nontemporal_load((const f32x4*)(Kc + (size_t)row * 1024 + cc * 4)); }
#pragma unroll
    for (int k = 0; k < 16; ++k) { const int ch = tid + (it0 + k) * 512, row = ch >> 6, cc = ch & 63; *(LAS u32x2*)(KV + row * 528 + cc * 8) = pack4(t[k]); }
  }
  f32x4 tv[16];
#pragma unroll
  for (int k = 0; k < 16; ++k) { const int ch = tid + k * 512, row = ch >> 6, cc = ch & 63; tv[k] = __builtin_nontemporal_load((const f32x4*)(Vc + (size_t)row * 1024 + cc * 4)); }
  __syncthreads();
#pragma unroll
  for (int t2 = 0; t2 < 2; ++t2) {
    const int n = 2 * w + t2;
    f32x4 s = (f32x4){0.f, 0.f, 0.f, 0.f};
#pragma unroll
    for (int ks = 0; ks < 8; ++ks) s = MFMA16(ldfrag(KV, 16 * n + fr, 32 * ks + 8 * fq, 528), Qf[ks], s);
    if (fr < 8) *(LAS f32x4*)(Sc + fr * 256 + 16 * n + 4 * fq) = s;
  }
  __syncthreads();
#pragma unroll
  for (int k = 0; k < 16; ++k) { const int ch = tid + k * 512, row = ch >> 6, cc = ch & 63; *(LAS u32x2*)(KV + row * 528 + cc * 8) = pack4(tv[k]); }
  {
    f32x4 t[16];
#pragma unroll
    for (int k = 0; k < 16; ++k) { const int ch = tid + (16 + k) * 512, row = ch >> 6, cc = ch & 63; t[k] = __builtin_nontemporal_load((const f32x4*)(Vc + (size_t)row * 1024 + cc * 4)); }
    {
      f32x4 sv = *(const LAS f32x4*)(Sc + w * 256 + 4 * lane);
      const float mx = wave_max(fmaxf(fmaxf(sv[0], sv[1]), fmaxf(sv[2], sv[3])));
      sv[0] = __expf(sv[0] - mx); sv[1] = __expf(sv[1] - mx); sv[2] = __expf(sv[2] - mx); sv[3] = __expf(sv[3] - mx);
      const float inv = 1.0f / wave_sum(sv[0] + sv[1] + sv[2] + sv[3]);
      *(LAS u32x2*)(Pb + w * 528 + lane * 8) = pack4(sv * inv);
    }
#pragma unroll
    for (int k = 0; k < 16; ++k) { const int ch = tid + (16 + k) * 512, row = ch >> 6, cc = ch & 63; *(LAS u32x2*)(KV + row * 528 + cc * 8) = pack4(t[k]); }
  }
  __syncthreads();
#pragma unroll
  for (int t2 = 0; t2 < 2; ++t2) {
    const int n = 2 * w + t2;
    f32x4 o = (f32x4){0.f, 0.f, 0.f, 0.f};
#pragma unroll
    for (int ks = 0; ks < 8; ++ks) o = MFMA16(ldfrag_tr(KV, 32 * ks + 8 * fq, 32 * ks + 8 * fq + 4, 16 * n, 528, lane), ldfrag(Pb, fr, 32 * ks + 8 * fq, 528), o);
    if (fr < 8) *(u32x2*)(ACAT + (size_t)(r0 + fr) * 4096 + 3072 + h * 256 + 16 * n + 4 * fq) = pack4(o);
  }
}

__device__ __forceinline__ void phase_mixers(const Params& p, LAS unsigned char* lds, int rep) {
  unsigned* ctr = (unsigned*)(p.ws + WS_CTL) + rep;
  LAS unsigned* slot = (LAS unsigned*)(lds + LDS_CTL);
  unsigned nxt = 0u;
  if (threadIdx.x == 0) nxt = atomicAdd(ctr, 1u);
  for (;;) {
    __syncthreads();
    if (threadIdx.x == 0) *slot = nxt;
    __syncthreads();
    const int u = (int)__builtin_amdgcn_readfirstlane(*slot);
    if (u >= 2304) break;
    if (threadIdx.x == 0) nxt = atomicAdd(ctr, 1u);
    if (u < 128) mix_ret_prompt(p, lds, u);
    else {
      const int v = u - 128, g = v / 17, s = v % 17;
      if (s < 8) mix_ret_sample(p, lds, g * 8 + s);
      else if (s < 12) mix_ma_sample(p, lds, g * 4 + (s - 8));
      else if (s < 14) mix_ma_prompt(p, lds, g * 2 + (s - 12));
      else if (s < 16) mix_sg_prompt(p, lds, g * 2 + (s - 14));
      else mix_sg_sample(p, lds, g);
    }
  }
}

__device__ __forceinline__ void phase_retpost(const Params& p) {
  int tid = threadIdx.x; asm volatile("" : "+v"(tid));
  const int w = tid >> 6, lane = tid & 63;
  unsigned char* ws = p.ws;
  const bf16_t* RO = (const bf16_t*)(ws + WS_RO); const bf16_t* RG = (const bf16_t*)(ws + WS_RG);
  bf16_t* ACAT = (bf16_t*)(ws + WS_ACAT);
  for (int pr0 = (blockIdx.x * 8 + w) * 8; pr0 < TOKP * 8; pr0 += gridDim.x * 8 * 8) {
    u32x2 xr[8], sr[8];
#pragma unroll
    for (int q = 0; q < 8; ++q) {
      const int pr = pr0 + q, r = pr >> 3, h = pr & 7;
      const size_t o = (size_t)r * 2048 + h * 256 + 4 * lane;
      xr[q] = *(const u32x2*)(RO + o);
      sr[q] = *(const u32x2*)(RG + o);
    }
#pragma unroll
    for (int q = 0; q < 8; ++q) {
      const int pr = pr0 + q, r = pr >> 3, h = pr & 7;
      const f32x4 x = unpack4(xr[q]);
      const float mean = wave_sum(x[0] + x[1] + x[2] + x[3]) * (1.0f / 256.0f);
      const f32x4 d = x - mean;
      const float var = wave_sum(d[0] * d[0] + d[1] * d[1] + d[2] * d[2] + d[3] * d[3]) * (1.0f / 256.0f);
      const float rstd = rsqrtf(var + LN_EPS);
      const f32x4 gn = *(const f32x4*)(p.in[12] + h * 256 + 4 * lane);
      const f32x4 sg = unpack4(sr[q]);
      *(u32x2*)(ACAT + (size_t)r * 4096 + 1024 + h * 256 + 4 * lane) = pack4(d * rstd * gn * sg);
    }
  }
}

__device__ __forceinline__ void ln_load_row(const Params& p, const float* src, int which, int r, int lane, f32x4 (&x)[8]) {
  const float* part = (const float*)(p.ws + WS_PART);
  const float* s = src + (size_t)r * 2048;
  const float* rs = which == 0 ? (r < TOKP ? p.in[0] + (size_t)r * 2048 : p.in[1] + (size_t)(r - TOKP) * 2048) : (const float*)(p.ws + WS_X1) + (size_t)r * 2048;
  const int pm = r >> 8, gid = pm >> 3, fm = gid * 8, gsz = (36 - fm) < 8 ? (36 - fm) : 8;
#pragma unroll
  for (int k = 0; k < 8; ++k) {
    const int wg = gid * 64 + k * gsz + (pm - fm), off = wg % 36, xcd = wg / 36;
    if (off >= 32) {
      const int j = (off - 32) * 8 + xcd;
      f32x4 v = *(const f32x4*)(rs + 256 * k + 4 * lane) * ALPHA;
      const float* pp = part + (size_t)j * 8 * 65536 + (r & 255) * 256 + 4 * lane;
      f32x4 t[8];
#pragma unroll
      for (int q = 0; q < 8; ++q) t[q] = *(const f32x4*)(pp + (size_t)q * 65536);
#pragma unroll
      for (int q = 0; q < 8; ++q) v += t[q];
      x[k] = v;
    } else x[k] = __builtin_nontemporal_load((const f32x4*)(s + 256 * k + 4 * lane));
  }
}
__device__ __forceinline__ void ln_finish_row(int r, int lane, f32x4 (&x)[8], float* dstf, bf16_t* dstb, const float* g, const float* bta) {
  float sm = 0.f;
#pragma unroll
  for (int k = 0; k < 8; ++k) sm += x[k][0] + x[k][1] + x[k][2] + x[k][3];
  const float mean = wave_sum(sm) * (1.0f / 2048.0f);
  float q = 0.f;
#pragma unroll
  for (int k = 0; k < 8; ++k) { x[k] = x[k] - mean; q += x[k][0] * x[k][0] + x[k][1] * x[k][1] + x[k][2] * x[k][2] + x[k][3] * x[k][3]; }
  const float rstd = rsqrtf(wave_sum(q) * (1.0f / 2048.0f) + LN_EPS);
#pragma unroll
  for (int k = 0; k < 8; ++k) {
    const int col = 256 * k + 4 * lane;
    const f32x4 gg = *(const f32x4*)(g + col), bb = *(const f32x4*)(bta + col);
    const f32x4 y = x[k] * rstd * gg + bb;
    if (dstb) { *(f32x4*)(dstf + (size_t)r * 2048 + col) = y; *(u32x2*)(dstb + (size_t)r * 2048 + col) = pack4(y); }
    else __builtin_nontemporal_store(y, (f32x4*)(dstf + (size_t)r * 2048 + col));
  }
}
__device__ __forceinline__ void phase_ln(const Params& p, const float* src, float* dstf, bf16_t* dstb, const float* g, const float* bta, int which) {
  int tid = threadIdx.x; asm volatile("" : "+v"(tid));
  const int w = tid >> 6, lane = tid & 63;
  const int nw = gridDim.x * 8;
  for (int r = blockIdx.x * 8 + w; r < NTOK; r += 2 * nw) {
    const int r2 = r + nw;
    f32x4 xa[8], xb[8];
    ln_load_row(p, src, which, r, lane, xa);
    if (r2 < NTOK) ln_load_row(p, src, which, r2, lane, xb);
    ln_finish_row(r, lane, xa, dstf, dstb, g, bta);
    if (r2 < NTOK) ln_finish_row(r2, lane, xb, dstf, dstb, g, bta);
  }
}

__device__ __forceinline__ void merge_split_reduce(const Params& p) {
  int tid = threadIdx.x; asm volatile("" : "+v"(tid));
  const int j = blockIdx.x >> 3, sl = blockIdx.x & 7;
  int pm, pn; static_tile(36, 8, 256 + j, pm, pn);
  const float* pt = (const float*)(p.ws + WS_PART) + (size_t)j * 8 * 65536 + sl * 8192;
  bf16_t* mb = (bf16_t*)(p.ws + WS_MERGEDB) + ((size_t)pm * 256 + sl * 32) * 2048 + pn * 256;
#pragma unroll
  for (int it = 0; it < 4; ++it) {
    const int e = (it * 512 + tid) * 4, rl = e >> 8, cl = e & 255;
    f32x4 t[8];
#pragma unroll
    for (int q = 0; q < 8; ++q) t[q] = *(const f32x4*)(pt + (size_t)q * 65536 + e);
    f32x4 v = t[0];
#pragma unroll
    for (int q = 1; q < 8; ++q) v += t[q];
    *(u32x2*)(mb + (size_t)rl * 2048 + cl) = pack4(v);
  }
}

__device__ __forceinline__ void ffn_split_reduce(const Params& p) {
  int tid = threadIdx.x; asm volatile("" : "+v"(tid));
  bf16_t* act = (bf16_t*)(p.ws + WS_ACT);
  for (int wk = blockIdx.x; wk < 384; wk += gridDim.x) {
    const int t = wk >> 3, sl = wk & 7;
    int pm, pn; static_tile(36, 44, 1536 + t, pm, pn);
    const float* pt = (const float*)(p.ws + WS_PART) + (size_t)t * 4 * 65536 + sl * 8192;
#pragma unroll
    for (int it = 0; it < 2; ++it) {
      const int idx = it * 512 + tid, rl = idx >> 5, g5 = idx & 31;
      const int bj = g5 >> 4, wc = (g5 >> 2) & 3, lg = g5 & 3;
      const int cl = 128 * bj + 32 * wc + 4 * lg;
      f32x4 tg[4], tu[4];
#pragma unroll
      for (int q = 0; q < 4; ++q) { tg[q] = *(const f32x4*)(pt + (size_t)q * 65536 + rl * 256 + cl); tu[q] = *(const f32x4*)(pt + (size_t)q * 65536 + rl * 256 + cl + 16); }
      const f32x4 g = tg[0] + tg[1] + tg[2] + tg[3], uu = tu[0] + tu[1] + tu[2] + tu[3];
      f32x4 v; v[0] = siluf_(g[0]) * uu[0]; v[1] = siluf_(g[1]) * uu[1]; v[2] = siluf_(g[2]) * uu[2]; v[3] = siluf_(g[3]) * uu[3];
      *(u32x2*)(act + (size_t)(pm * 256 + sl * 32 + rl) * DFF + pn * 128 + 64 * bj + 16 * wc + 4 * lg) = pack4(v);
    }
  }
}

#define XB_TMO      128
#define XB_XCNT(j)  (256  + 64 * (j))
#define XB_XSUB(j)  (1280 + 64 * (j))
#define XB_XGEN(j)  (2304 + 64 * (j))
#define XB_TOP      3328
#define XB_TOPGEN   3392
#define XCD_BAR_WORDS 3456
#define XB_SPIN_CAP (1u << 18)
__device__ __forceinline__ unsigned xb_ld(unsigned* p)              { return __hip_atomic_load(p, __ATOMIC_RELAXED, __HIP_MEMORY_SCOPE_AGENT); }
__device__ __forceinline__ unsigned xb_add(unsigned* p, unsigned v) { return __hip_atomic_fetch_add(p, v, __ATOMIC_RELAXED, __HIP_MEMORY_SCOPE_AGENT); }
__device__ __forceinline__ unsigned xb_xcc_id() { return (unsigned)__builtin_amdgcn_s_getreg((3 << 11) | 20) & 0xFu; }
#define XB_SPIN(cond, bar) do { unsigned _sp = 0; while (cond) { __builtin_amdgcn_s_sleep(1); \
    if ((++_sp & 255u) == 0u) { if (xb_ld(&(bar)[XB_TMO])) break; if (_sp > XB_SPIN_CAP) { atomicAdd(&(bar)[XB_TMO], 1u); break; } } } } while (0)
struct XcdBarrier { unsigned* bar; unsigned x; volatile LAS unsigned* st; };
__device__ __forceinline__ XcdBarrier xcd_barrier_post(unsigned* bar, volatile LAS unsigned* st) {
    XcdBarrier b; b.bar = bar; b.x = xb_xcc_id(); b.st = st;
    if (threadIdx.x == 0) (void)xb_add(&bar[XB_XCNT(b.x)], 1u);
    return b;
}
__device__ __forceinline__ void xcd_barrier_complete(unsigned* bar, unsigned x, unsigned& nloc, unsigned& nx) {
    const unsigned G = gridDim.x * gridDim.y * gridDim.z;
    unsigned sum, cnt, mine, sp = 0u;
    for (;;) {
        sum = 0u; cnt = 0u; mine = 0u;
#pragma unroll
        for (unsigned j = 0; j < 16; ++j) { const unsigned c = xb_ld(&bar[XB_XCNT(j)]); sum += c; cnt += (c > 0u) ? 1u : 0u; mine = (j == x) ? c : mine; }
        if (sum == G) break;
        __builtin_amdgcn_s_sleep(1);
        if ((++sp & 255u) == 0u) { if (xb_ld(&bar[XB_TMO])) break; if (sp > XB_SPIN_CAP) { atomicAdd(&bar[XB_TMO], 1u); break; } }
    }
    nloc = mine > 0u ? mine : 1u; nx = cnt > 0u ? cnt : 1u;
}
__device__ __forceinline__ void xcd_barrier(const XcdBarrier& b) {
    asm volatile("s_waitcnt vmcnt(0)" ::: "memory");
    __syncthreads();
    if (threadIdx.x == 0) {
        unsigned* bar = b.bar;
        __builtin_amdgcn_s_waitcnt(0);
        unsigned nloc = b.st[0], nx = b.st[1];
        if (nloc == 0u) { xcd_barrier_complete(bar, b.x, nloc, nx); b.st[0] = nloc; b.st[1] = nx; }
        const unsigned old = xb_add(&bar[XB_XSUB(b.x)], 1u);
        const unsigned gen = old / nloc;
        if (old + 1u == (gen + 1u) * nloc) {
            __builtin_amdgcn_fence(__ATOMIC_RELEASE, "agent");
            asm volatile("s_waitcnt vmcnt(0)" ::: "memory");
            const unsigned og = xb_add(&bar[XB_TOP], 1u);
            const unsigned tg = og / nx;
            if (og + 1u == (tg + 1u) * nx) xb_add(&bar[XB_TOPGEN], 1u);
            else XB_SPIN(xb_ld(&bar[XB_TOPGEN]) == tg, bar);
            __builtin_amdgcn_fence(__ATOMIC_ACQUIRE, "agent");
            xb_add(&bar[XB_XGEN(b.x)], 1u);
            asm volatile("s_waitcnt vmcnt(0)" ::: "memory");
        } else {
            XB_SPIN(xb_ld(&bar[XB_XGEN(b.x)]) == gen, bar);
            __builtin_amdgcn_fence(__ATOMIC_ACQUIRE, "agent");
            asm volatile("s_waitcnt vmcnt(0)" ::: "memory");
        }
    }
    __syncthreads();
}

__global__ void __launch_bounds__(512, 2) fwd_megakernel(Params p) {
  extern __shared__ __attribute__((aligned(16))) unsigned char shm[];
  LAS unsigned char* lds = (LAS unsigned char*)shm;
  cg::grid_group grid = cg::this_grid();
  unsigned char* ws = p.ws;
  if (p.ph_hi > 1000) grid.sync();
  volatile LAS unsigned* xst = (volatile LAS unsigned*)(lds + LDS_CTL - 16);
  if (threadIdx.x == 0) { xst[0] = 0u; xst[1] = 0u; }
  __syncthreads();
  const XcdBarrier xb = xcd_barrier_post((unsigned*)(ws + WS_BAR), xst);
#ifndef PROBE_PH
#define PROBE_PH -1
#endif
  for (int ph = p.ph_lo; ph < p.ph_hi; ++ph) {
   for (int rep = 0; rep < (ph == PROBE_PH ? 2 : 1); ++rep) {
    if (rep) xcd_barrier(xb);
    if (ph == 1 || ph == 4 || ph == 5 || ph == 7 || ph == 8) {
      const int gph = ph == 1 ? 0 : ph == 4 ? 1 : ph == 5 ? 2 : ph == 7 ? 3 : 4;
      const unsigned ldB = gph == 1 ? 4096u * 2u : gph == 4 ? 5632u * 2u : 2048u * 2u;
      gemm_phase(p, lds, gph, ldB);
      if (gph == 0) conv_queue(p, lds, (unsigned*)(ws + WS_CTL) + 4, 7680, 16384);
      if (gph == 3) conv_queue(p, lds, (unsigned*)(ws + WS_CTL) + 5, 16384, 19200);
      if (gph == 1 && gridDim.x == 256) { xcd_barrier(xb); merge_split_reduce(p); }
      if (gph == 3 && gridDim.x == 256) { xcd_barrier(xb); ffn_split_reduce(p); }
    } else if (ph == 0) phase_prep(p, lds);
    else if (ph == 2) phase_mixers(p, lds, rep);
    else if (ph == 3) phase_retpost(p);
    else if (ph == 6) phase_ln(p, (const float*)(ws + WS_X1), (float*)(ws + WS_X1), (bf16_t*)(ws + WS_X1B), p.in[18], p.in[19], 0);
    else phase_ln(p, (const float*)(ws + WS_YPRE), p.out + O_Y, nullptr, p.in[23], p.in[24], 1);
   }
    if (ph + 1 < p.ph_hi) xcd_barrier(xb);
  }
}

extern "C" void kernel_launch(void* const* d_in, const int* in_sizes, int n_in, void* d_out, int out_size, void* d_ws, size_t ws_size, hipStream_t stream) {
  static int grid_blocks = 0;
  if (grid_blocks == 0) {
    if (n_in != 25 || ws_size < WS_END) { fprintf(stderr, "kernel_launch: unexpected n_in %d or ws_size %zu (need %zu)\n", n_in, ws_size, (size_t)WS_END); grid_blocks = -1; return; }
    int dev = 0, cus = 0, per_cu = 0;
    hipGetDevice(&dev);
    hipDeviceGetAttribute(&cus, hipDeviceAttributeMultiprocessorCount, dev);
    hipFuncSetAttribute((const void*)fwd_megakernel, hipFuncAttributeMaxDynamicSharedMemorySize, LDS_BYTES);
    hipOccupancyMaxActiveBlocksPerMultiprocessor(&per_cu, (const void*)fwd_megakernel, 512, LDS_BYTES);
    if (per_cu < 1) { fprintf(stderr, "kernel_launch: occupancy query returned %d\n", per_cu); per_cu = 1; }
    grid_blocks = cus * per_cu;
    (void)hipGetLastError();
  }
  if (grid_blocks < 0) return;
  if (hipMemsetAsync((char*)d_ws + WS_CTL, 0, WS_CTL_BYTES, stream) != hipSuccess) { fprintf(stderr, "kernel_launch: memset of control words failed\n"); return; }
  Params p{};
  for (int i = 0; i < 25; ++i) p.in[i] = (const float*)d_in[i];
  p.out = (float*)d_out; p.ws = (unsigned char*)d_ws; p.ph_lo = 0; p.ph_hi = 10;
  void* args[] = {&p};
  hipError_t e = hipLaunchCooperativeKernel((const void*)fwd_megakernel, dim3(grid_blocks), dim3(512), args, LDS_BYTES, stream);
  if (e != hipSuccess) fprintf(stderr, "cooperative launch failed: %s (grid %d)\n", hipGetErrorString(e), grid_blocks);
}
```
